# Optimizing an MI355X kernel written in HIP

```python
import math
import jax, jax.numpy as jnp
from jax import lax
import numpy as np

D_MODEL = 1024
BATCH = 8
SEQ = 2048
DEPTH = 2
DEC_BATCH = 128
DEC_SEQ = 1
PAST_LEN = 16384
PAGE_SIZE = 128

N_MIXERS = 2
N_META = 16
RMS_EPS = 1e-6
D_RNN = -(-4 * D_MODEL // (3 * 128)) * 128
LRU_BLOCKS = 16
LRU_BW = D_RNN // LRU_BLOCKS
CONV_W = 4
LRU_C = 8.0
S5_GROUP = 16
S5_GROUPS = D_MODEL // S5_GROUP
S5_STATE = 64
CHUNK = 128
D_FF = -(-8 * D_MODEL // (3 * 256)) * 256
N_LRU_LAYERS = (DEPTH + N_MIXERS - 1) // N_MIXERS
N_S5_LAYERS = DEPTH // N_MIXERS

kernel_name = 'hybrid_rglru_s5_meta_decode_step'


def rms_norm(x, g):
    xf = x.astype(jnp.float32)
    y = xf * lax.rsqrt(jnp.mean(xf * xf, axis=-1, keepdims=True) + RMS_EPS)
    return (y * g.astype(jnp.float32)).astype(x.dtype)


def swiglu(x, w_in, w_out):
    gate, up = jnp.split(x @ w_in, 2, axis=-1)
    return (jax.nn.silu(gate) * up) @ w_out


def causal_conv(x, buf, w, b):
    T = x.shape[1]
    xp = jnp.concatenate([buf.astype(x.dtype), x], axis=1)
    y = b + sum(w[k] * xp[:, k:k + T] for k in range(CONV_W))
    return y, xp[:, T:]


def lru_scan(a, b, h0):
    def step(h, ab):
        a_t, b_t = ab
        h = a_t * h + b_t
        return h, h
    h_last, hs = lax.scan(step, h0, (a.swapaxes(0, 1), b.swapaxes(0, 1)))
    return h_last, hs.swapaxes(0, 1)


def rglru_mixer(xn, h0, conv0, w_in, w_conv, b_conv, w_a, b_a, w_x, b_x, lam, w_out):
    B, T, _ = xn.shape
    xb, gb = jnp.split(xn @ w_in, 2, axis=-1)
    xc, conv_new = causal_conv(xb, conv0, w_conv, b_conv)
    xblk = xc.reshape(B, T, LRU_BLOCKS, LRU_BW)
    r = jax.nn.sigmoid(jnp.einsum('bthi,hij->bthj', xblk, w_a).reshape(B, T, D_RNN) + b_a)
    ig = jax.nn.sigmoid(jnp.einsum('bthi,hij->bthj', xblk, w_x).reshape(B, T, D_RNN) + b_x)
    log_a = -LRU_C * r.astype(jnp.float32) * jax.nn.softplus(-lam.astype(jnp.float32))
    a = jnp.exp(log_a)
    b = jnp.sqrt(-jnp.expm1(2.0 * log_a)) * (ig * xc).astype(jnp.float32)
    h_last, hs = lru_scan(a, b, h0.astype(jnp.float32))
    out = (hs.astype(xn.dtype) * jax.nn.gelu(gb)) @ w_out
    return out, h_last, conv_new


def _combine(e1, e2):
    a1, b1 = e1
    a2, b2 = e2
    return a1 * a2, a2 * b1 + b2


def s5_block(h0, u, abar, bbar, c):
    bu = jnp.einsum('btgc,gpc->btgp', u.astype(jnp.complex64), bbar)
    a = jnp.broadcast_to(abar, bu.shape)
    a_cum, h_loc = lax.associative_scan(_combine, (a, bu), axis=1)
    h = h_loc + a_cum * h0[:, None]
    y = jnp.real(jnp.einsum('gcp,btgp->btgc', c, h))
    return h[:, -1], y


def s5_mixer(xn, h0_re, h0_im, lead, lam_re, lam_im, log_dt, b_re, b_im, c_re, c_im, d_skip, w_out):
    B, T, D = xn.shape
    f32 = jnp.float32
    A = lax.complex(lam_re.astype(f32), lam_im.astype(f32))
    dt = jnp.exp(log_dt.astype(f32))[:, None]
    abar = jnp.exp(dt * A)
    bbar = ((abar - 1.0) / A)[:, :, None] * lax.complex(b_re.astype(f32), b_im.astype(f32))
    c = lax.complex(c_re.astype(f32), c_im.astype(f32))
    u = xn.astype(f32).reshape(B, T, S5_GROUPS, S5_GROUP)
    h0 = lax.complex(h0_re.astype(f32), h0_im.astype(f32))
    h, y_lead = s5_block(h0, u[:, :lead], abar, bbar, c)
    ys = [y_lead]
    n_rest = (T - lead) // CHUNK
    if n_rest > 0:
        u_rest = u[:, lead:].reshape(B, n_rest, CHUNK, S5_GROUPS, S5_GROUP).swapaxes(0, 1)
        h, y_rest = lax.scan(lambda hc, uc: s5_block(hc, uc, abar, bbar, c), h, u_rest)
        ys.append(y_rest.swapaxes(0, 1).reshape(B, T - lead, S5_GROUPS, S5_GROUP))
    y = jnp.concatenate(ys, axis=1).reshape(B, T, D) + d_skip.astype(f32) * xn.astype(f32)
    z = jax.nn.gelu(y).astype(xn.dtype)
    za, zb = jnp.split(z @ w_out, 2, axis=-1)
    return za * jax.nn.sigmoid(zb), jnp.real(h), jnp.imag(h)


def setup_inputs(seed: int = 0) -> dict:
    key = jax.random.key(seed)
    ks = jax.random.split(key, 32)
    nrm = jax.random.normal
    f32 = jnp.float32
    L1, L2 = N_LRU_LAYERS, N_S5_LAYERS
    a0 = jax.random.uniform(ks[14], (L1, D_RNN), f32, 0.9, 0.999)
    n_idx = jnp.arange(S5_STATE, dtype=f32)
    return {
        'x_prompt': nrm(ks[0], (BATCH, SEQ, D_MODEL), f32),
        'x_sample': nrm(ks[1], (DEC_BATCH, DEC_SEQ, D_MODEL), f32),
        'state_lru_h': 0.5 * nrm(ks[2], (L1, DEC_BATCH, D_RNN), f32),
        'state_lru_conv': nrm(ks[3], (L1, DEC_BATCH, CONV_W - 1, D_RNN), f32),
        'state_s5_re': 0.5 * nrm(ks[4], (L2, DEC_BATCH, S5_GROUPS, S5_STATE), f32),
        'state_s5_im': 0.5 * nrm(ks[5], (L2, DEC_BATCH, S5_GROUPS, S5_STATE), f32),
        'meta_tokens': nrm(ks[6], (N_META, D_MODEL), f32),
        'norm_gains': 1.0 + 0.1 * nrm(ks[7], (DEPTH, 4, D_MODEL), f32),
        'lru_w_in': nrm(ks[8], (L1, D_MODEL, 2 * D_RNN), f32) * D_MODEL ** -0.5,
        'lru_w_conv': nrm(ks[9], (L1, CONV_W, D_RNN), f32) * CONV_W ** -0.5,
        'lru_b_conv': 0.01 * nrm(ks[10], (L1, D_RNN), f32),
        'lru_w_a': nrm(ks[11], (L1, LRU_BLOCKS, LRU_BW, LRU_BW), f32) * LRU_BW ** -0.5,
        'lru_b_a': 0.1 * nrm(ks[12], (L1, D_RNN), f32),
        'lru_w_x': nrm(ks[13], (L1, LRU_BLOCKS, LRU_BW, LRU_BW), f32) * LRU_BW ** -0.5,
        'lru_b_x': 0.1 * nrm(ks[15], (L1, D_RNN), f32),
        'lru_lambda': jnp.log(a0) - jnp.log1p(-a0),
        'lru_w_out': nrm(ks[16], (L1, D_RNN, D_MODEL), f32) * D_RNN ** -0.5,
        's5_lambda_re': -0.5 + 0.01 * nrm(ks[17], (L2, S5_GROUPS, S5_STATE), f32),
        's5_lambda_im': math.pi * n_idx + 0.01 * nrm(ks[18], (L2, S5_GROUPS, S5_STATE), f32),
        's5_log_dt': jax.random.uniform(ks[19], (L2, S5_GROUPS), f32, math.log(0.001), math.log(0.1)),
        's5_b_re': nrm(ks[20], (L2, S5_GROUPS, S5_STATE, S5_GROUP), f32) * (2 * S5_GROUP) ** -0.5,
        's5_b_im': nrm(ks[21], (L2, S5_GROUPS, S5_STATE, S5_GROUP), f32) * (2 * S5_GROUP) ** -0.5,
        's5_c_re': nrm(ks[22], (L2, S5_GROUPS, S5_GROUP, S5_STATE), f32) * S5_STATE ** -0.5,
        's5_c_im': nrm(ks[23], (L2, S5_GROUPS, S5_GROUP, S5_STATE), f32) * S5_STATE ** -0.5,
        's5_d': nrm(ks[24], (L2, D_MODEL), f32),
        's5_w_out': nrm(ks[25], (L2, D_MODEL, 2 * D_MODEL), f32) * D_MODEL ** -0.5,
        'ffn_w_in': nrm(ks[26], (DEPTH, D_MODEL, 2 * D_FF), f32) * D_MODEL ** -0.5,
        'ffn_w_out': nrm(ks[27], (DEPTH, D_FF, D_MODEL), f32) * D_FF ** -0.5,
    }


def reference(x_prompt, x_sample, state_lru_h, state_lru_conv, state_s5_re, state_s5_im,
              meta_tokens, norm_gains, lru_w_in, lru_w_conv, lru_b_conv, lru_w_a, lru_b_a,
              lru_w_x, lru_b_x, lru_lambda, lru_w_out, s5_lambda_re, s5_lambda_im, s5_log_dt,
              s5_b_re, s5_b_im, s5_c_re, s5_c_im, s5_d, s5_w_out, ffn_w_in, ffn_w_out):
    Bp = x_prompt.shape[0]
    x_p = jnp.concatenate(
        [jnp.broadcast_to(meta_tokens.astype(x_prompt.dtype)[None], (Bp, N_META, D_MODEL)), x_prompt], axis=1)
    x_s = x_sample
    lru_h_p, lru_cv_p, s5_re_p, s5_im_p = [], [], [], []
    lru_h_s, lru_cv_s, s5_re_s, s5_im_s = [], [], [], []
    for i in range(DEPTH):
        g = norm_gains[i]
        j = i // N_MIXERS
        xn_p = rms_norm(x_p, g[0])
        xn_s = rms_norm(x_s, g[0])
        if i % N_MIXERS == 0:
            prm = (lru_w_in[j], lru_w_conv[j], lru_b_conv[j], lru_w_a[j], lru_b_a[j],
                   lru_w_x[j], lru_b_x[j], lru_lambda[j], lru_w_out[j])
            m_p, h_p, cv_p = rglru_mixer(xn_p, jnp.zeros((Bp, D_RNN), jnp.float32),
                                         jnp.zeros((Bp, CONV_W - 1, D_RNN), x_p.dtype), *prm)
            m_s, h_s, cv_s = rglru_mixer(xn_s, state_lru_h[j], state_lru_conv[j], *prm)
            lru_h_p.append(h_p); lru_cv_p.append(cv_p)
            lru_h_s.append(h_s); lru_cv_s.append(cv_s)
        else:
            prm = (s5_lambda_re[j], s5_lambda_im[j], s5_log_dt[j], s5_b_re[j], s5_b_im[j],
                   s5_c_re[j], s5_c_im[j], s5_d[j], s5_w_out[j])
            zeros_state = jnp.zeros((Bp, S5_GROUPS, S5_STATE), jnp.float32)
            m_p, re_p, im_p = s5_mixer(xn_p, zeros_state, zeros_state, N_META, *prm)
            m_s, re_s, im_s = s5_mixer(xn_s, state_s5_re[j], state_s5_im[j], x_s.shape[1], *prm)
            s5_re_p.append(re_p); s5_im_p.append(im_p)
            s5_re_s.append(re_s); s5_im_s.append(im_s)
        x_p = x_p + rms_norm(m_p, g[1])
        x_s = x_s + rms_norm(m_s, g[1])
        x_p = x_p + rms_norm(swiglu(rms_norm(x_p, g[2]), ffn_w_in[i], ffn_w_out[i]), g[3])
        x_s = x_s + rms_norm(swiglu(rms_norm(x_s, g[2]), ffn_w_in[i], ffn_w_out[i]), g[3])
    y_prompt = x_p[:, N_META:]
    y_sample = x_s
    new_lru_h_prompt = jnp.stack(lru_h_p)
    new_lru_conv_prompt = jnp.stack(lru_cv_p)
    new_s5_re_prompt = jnp.stack(s5_re_p)
    new_s5_im_prompt = jnp.stack(s5_im_p)
    new_lru_h_sample = jnp.stack(lru_h_s)
    new_lru_conv_sample = jnp.stack(lru_cv_s)
    new_s5_re_sample = jnp.stack(s5_re_s)
    new_s5_im_sample = jnp.stack(s5_im_s)
    return (y_prompt, y_sample, new_lru_h_prompt, new_lru_conv_prompt, new_s5_re_prompt, new_s5_im_prompt,
            new_lru_h_sample, new_lru_conv_sample, new_s5_re_sample, new_s5_im_sample)
```

```cpp
#include <hip/hip_runtime.h>
#include <cstdio>
#include <cstdint>
namespace pg8 {
#define PG8_LAS __attribute__((address_space(3)))
typedef unsigned short bf16_t;
typedef short bf16x8 __attribute__((ext_vector_type(8)));
typedef float f32x4 __attribute__((ext_vector_type(4)));
typedef unsigned u32x4 __attribute__((ext_vector_type(4)));
constexpr int BM = 256, BK = 64, HALF = 128, HTB = HALF * BK * 2  , STAGE_BYTES = 8 * HTB, NXCD = 8, WGM = 8;

__host__ __device__ __forceinline__ int lds_byte(int r, int c) { const int st = (r >> 4) * 2 + (c >> 5), rr = r & 15, cc = c & 31, ob = rr * 64 + cc * 2; return st * 1024 + (ob ^ (((ob >> 9) & 1) << 5)); }
__host__ __device__ __forceinline__ void stage_rc(int b, int& R, int& C) { const int st = b / 1024, sb = b % 1024, swz = sb ^ (((sb >> 9) & 1) << 5); R = (st >> 1) * 16 + swz / 64; C = (st & 1) * 32 + (swz % 64) / 2; }
__host__ __device__ __forceinline__ int perm32(int rho) { const int n = rho >> 4, i = rho & 15; return 8 * (i >> 2) + 4 * n + (i & 3); }

struct Unit { int pm, pn; };
struct Gemm { const bf16_t* A; const bf16_t* Bt; int M, N, K; };

struct StaticOrder {
    int nM, nN, nwg, G, c;
    __host__ __device__ void init(int M, int N, int G_, int c_) { nM = M / BM; nN = N / BM; nwg = nM * nN; G = G_; c = c_; }
    __host__ __device__ bool next(int i, Unit& u) const {
        const long L = (long)i * G + c; if (L >= nwg) return false;
        int wgid = (int)L; { const int q = nwg / NXCD, r = nwg % NXCD, xcd = wgid % NXCD, off = wgid / NXCD; wgid = (xcd < r ? xcd * (q + 1) : r * (q + 1) + (xcd - r) * q) + off; }
        const int nig = WGM * nN, gid = wgid / nig, fm = gid * WGM, gsz = (nM - fm) < WGM ? (nM - fm) : WGM;
        u.pm = fm + ((wgid % nig) % gsz); u.pn = (wgid % nig) / gsz; return true;
    }
    __device__ __forceinline__ void a_ready(const Unit&) const {}
    __device__ __forceinline__ void done(const Unit&) const {}
};

__device__ __forceinline__ unsigned cvt_pk_bf16(float lo, float hi) { unsigned r; asm volatile("v_cvt_pk_bf16_f32 %0, %1, %2" : "=v"(r) : "v"(lo), "v"(hi)); return r; }
typedef float f32x2 __attribute__((ext_vector_type(2)));
__device__ __forceinline__ f32x2 gelu_pk(f32x2 v) {
    const f32x2 av = __builtin_elementwise_abs(v), d = av * 0.2316418882f + 1.0f;
    f32x2 t; t.x = __builtin_amdgcn_rcpf(d.x); t.y = __builtin_amdgcn_rcpf(d.y);
    f32x2 q = t * 0.5307027145f + (-0.7265760135f); q = q * t + 0.7107068705f; q = q * t + (-0.142248368f); q = q * t + 0.127414796f; q = q * t;
    const f32x2 s = (v * v) * (-0.72134752044f);
    f32x2 e; e.x = __builtin_amdgcn_exp2f(s.x); e.y = __builtin_amdgcn_exp2f(s.y);
    const f32x2 m = v * (q * e), r = v - m;
    f32x2 o; o.x = v.x < 0.f ? m.x : r.x; o.y = v.y < 0.f ? m.y : r.y; return o;
}

template <int ACT  > struct EpiBf16 {
    static constexpr bool PERM = true, AFTER_DRAIN = false; static_assert(ACT == 0 || ACT == 1, "EpiBf16: ACT is 0 (none) or 1 (gelu_pk)");
    bf16_t* O; int ldc; const float* bias; int split_cols; size_t split_stride; float scale0;
    __device__ __forceinline__ void operator()(const f32x4 (&acc)[2][2][4][2], const Unit& u, int wr, int wc, int fr, int fq) const {
        const int row0 = u.pm * BM + wr * 64 + fr; int colt = u.pn * BM; bf16_t* base = O;
        float sc = 1.f; if (split_cols) { const int t = colt / split_cols; base += (size_t)t * split_stride; colt -= t * split_cols; if (t == 0) sc = scale0; }
        const int col0 = colt + wc * 32 + 8 * fq, bcol0 = u.pn * BM + wc * 32 + 8 * fq;
        f32x4 bv[2][2];
#pragma unroll
        for (int bj = 0; bj < 2; ++bj)
#pragma unroll
            for (int n = 0; n < 2; ++n) bv[bj][n] = bias ? *(const f32x4*)(bias + bcol0 + bj * HALF + 4 * n) : (f32x4){0.f, 0.f, 0.f, 0.f};
#pragma unroll
        for (int ai = 0; ai < 2; ++ai)
#pragma unroll
            for (int m = 0; m < 4; ++m) { bf16_t* rowp = base + (size_t)(row0 + ai * HALF + m * 16) * ldc + col0;
#pragma unroll
                for (int bj = 0; bj < 2; ++bj) { f32x4 v0 = acc[ai][bj][m][0] + bv[bj][0], v1 = acc[ai][bj][m][1] + bv[bj][1];
                    if (ACT == 1) { f32x2 a = gelu_pk((f32x2){v0[0], v0[1]}), b = gelu_pk((f32x2){v0[2], v0[3]}), c = gelu_pk((f32x2){v1[0], v1[1]}), d = gelu_pk((f32x2){v1[2], v1[3]});
                        v0 = (f32x4){a.x, a.y, b.x, b.y}; v1 = (f32x4){c.x, c.y, d.x, d.y}; }
                    v0 = v0 * sc; v1 = v1 * sc; u32x4 w; w.x = cvt_pk_bf16(v0[0], v0[1]); w.y = cvt_pk_bf16(v0[2], v0[3]); w.z = cvt_pk_bf16(v1[0], v1[1]); w.w = cvt_pk_bf16(v1[2], v1[3]);
                    *(u32x4*)(rowp + bj * HALF) = w; } }
    }
};

__device__ __forceinline__ float gelu_tanh_f(float x) {
    const float u = x * (1.0f + 0.044715f * x * x);
    const float e = __builtin_amdgcn_exp2f(-2.302208198f * u);
    return x * __builtin_amdgcn_rcpf(1.0f + e);
}
__device__ __forceinline__ float sigmoid_f(float x) { return __builtin_amdgcn_rcpf(1.0f + __builtin_amdgcn_exp2f(-1.442695041f * x)); }

struct EpiXG {
    static constexpr bool PERM = true, AFTER_DRAIN = false;
    bf16_t* O;
    __device__ __forceinline__ void operator()(const f32x4 (&acc)[2][2][4][2], const Unit& u, int wr, int wc, int fr, int fq) const {
        const int row0 = u.pm * BM + wr * 64 + fr, col0 = u.pn * BM + wc * 32 + 8 * fq;
#pragma unroll
        for (int ai = 0; ai < 2; ++ai)
#pragma unroll
            for (int m = 0; m < 4; ++m) { bf16_t* rowp = O + (size_t)(row0 + ai * HALF + m * 16) * 2816 + col0;
#pragma unroll
                for (int bj = 0; bj < 2; ++bj) { f32x4 v0 = acc[ai][bj][m][0], v1 = acc[ai][bj][m][1];
                    if (u.pn * BM + bj * HALF >= 1408) {
#pragma unroll
                        for (int j = 0; j < 4; ++j) { v0[j] = gelu_tanh_f(v0[j]); v1[j] = gelu_tanh_f(v1[j]); } }
                    u32x4 w; w.x = cvt_pk_bf16(v0[0], v0[1]); w.y = cvt_pk_bf16(v0[2], v0[3]); w.z = cvt_pk_bf16(v1[0], v1[1]); w.w = cvt_pk_bf16(v1[2], v1[3]);
                    *(u32x4*)(rowp + bj * HALF) = w; } }
    }
};
template <int ACT> struct EpiGated {
    static constexpr bool PERM = true, AFTER_DRAIN = false;
    bf16_t* O; int ldc;
    __device__ __forceinline__ void operator()(const f32x4 (&acc)[2][2][4][2], const Unit& u, int wr, int wc, int fr, int fq) const {
        const int row0 = u.pm * BM + wr * 64 + fr, col0 = u.pn * HALF + wc * 32 + 8 * fq;
#pragma unroll
        for (int ai = 0; ai < 2; ++ai)
#pragma unroll
            for (int m = 0; m < 4; ++m) { bf16_t* rowp = O + (size_t)(row0 + ai * HALF + m * 16) * ldc + col0;
                f32x4 o[2];
#pragma unroll
                for (int n = 0; n < 2; ++n)
#pragma unroll
                    for (int j = 0; j < 4; ++j) { const float a = acc[ai][0][m][n][j], b = acc[ai][1][m][n][j];
                        o[n][j] = (ACT == 0) ? (a * sigmoid_f(a)) * b : a * sigmoid_f(b); }
                u32x4 w; w.x = cvt_pk_bf16(o[0][0], o[0][1]); w.y = cvt_pk_bf16(o[0][2], o[0][3]); w.z = cvt_pk_bf16(o[1][0], o[1][1]); w.w = cvt_pk_bf16(o[1][2], o[1][3]);
                *(u32x4*)rowp = w; }
    }
};
struct EpiPlain {
    static constexpr bool PERM = true, AFTER_DRAIN = false;
    bf16_t* O; int ldc;
    __device__ __forceinline__ void operator()(const f32x4 (&acc)[2][2][4][2], const Unit& u, int wr, int wc, int fr, int fq) const {
        const int row0 = u.pm * BM + wr * 64 + fr, col0 = u.pn * BM + wc * 32 + 8 * fq;
#pragma unroll
        for (int ai = 0; ai < 2; ++ai)
#pragma unroll
            for (int m = 0; m < 4; ++m) { bf16_t* rowp = O + (size_t)(row0 + ai * HALF + m * 16) * ldc + col0;
#pragma unroll
                for (int bj = 0; bj < 2; ++bj) { const f32x4 v0 = acc[ai][bj][m][0], v1 = acc[ai][bj][m][1];
                    u32x4 w; w.x = cvt_pk_bf16(v0[0], v0[1]); w.y = cvt_pk_bf16(v0[2], v0[3]); w.z = cvt_pk_bf16(v1[0], v1[1]); w.w = cvt_pk_bf16(v1[2], v1[3]);
                    *(u32x4*)(rowp + bj * HALF) = w; } }
    }
};

template <class Epi, class Sched, bool ALIGN_EPI = false, bool SP2 = false>
__device__ __forceinline__ void gemm_phase(PG8_LAS unsigned char* lds, const Gemm g, const Sched& S, const Epi& E) {
    const int tid = threadIdx.x, wid = __builtin_amdgcn_readfirstlane(tid >> 6), lane = tid & 63, wr = wid >> 2, wc = wid & 3, fr = lane & 15, fq = lane >> 4;
    const int K = g.K, nt = K / BK;
    unsigned voffA[2], voffB[2];
#pragma unroll
    for (int i = 0; i < 2; ++i) { int R, C; stage_rc(tid * 16 + i * 8192, R, C); const int Rb = Epi::PERM ? ((R & ~31) + perm32(R & 31)) : R;
        voffA[i] = (unsigned)(R * K + C) * 2u; voffB[i] = (unsigned)(Rb * K + C) * 2u; }
    const size_t kstep = (size_t)(BK * 2);
    const size_t hstep = (size_t)HALF * K * 2;
    const size_t tstep = 2 * hstep;
    const unsigned ldsw = (unsigned)wid * 1024u;
    const int aoff = lds_byte(wr * 64 + fr, fq * 8), boff = lds_byte(wc * 32 + fr, fq * 8);
#define PG8_SA(b, h) (((b) * 2 + (h)) * HTB)
#define PG8_SB(b, h) ((4 + (b) * 2 + (h)) * HTB)
#define PG8_STAGE(bufoff, gbase, voff) do { _Pragma("unroll") for (int _i = 0; _i < 2; ++_i) \
        __builtin_amdgcn_global_load_lds((const unsigned*)((const char*)(gbase) + (voff)[_i]), (PG8_LAS unsigned*)(lds + (bufoff) + ldsw + _i * 8192), 16, 0, 0); } while (0)
#define PG8_LDA(dst, b, h) do { _Pragma("unroll") for (int m = 0; m < 4; ++m) _Pragma("unroll") for (int k = 0; k < 2; ++k) dst[m][k] = *(const PG8_LAS bf16x8*)(lds + PG8_SA(b, h) + aoff + m * 2048 + k * 1024); } while (0)
#define PG8_LDB(dst, b, h) do { _Pragma("unroll") for (int n = 0; n < 2; ++n) _Pragma("unroll") for (int k = 0; k < 2; ++k) dst[n][k] = *(const PG8_LAS bf16x8*)(lds + PG8_SB(b, h) + boff + n * 2048 + k * 1024); } while (0)
#define PG8_MMA(ai, bj, At, Bt) do { __builtin_amdgcn_s_setprio(1); _Pragma("unroll") for (int m = 0; m < 4; ++m) _Pragma("unroll") for (int n = 0; n < 2; ++n) _Pragma("unroll") for (int k = 0; k < 2; ++k) \
        acc[ai][bj][m][n] = __builtin_amdgcn_mfma_f32_16x16x32_bf16(Bt[n][k], At[m][k], acc[ai][bj][m][n], 0, 0, 0); __builtin_amdgcn_s_setprio(0); } while (0)
#define PG8_WAIT_V(n) asm volatile("s_waitcnt vmcnt(" #n ")" ::: "memory")
#define PG8_WAIT_L(n) asm volatile("s_waitcnt lgkmcnt(" #n ")" ::: "memory")
#define PG8_BAR __builtin_amdgcn_s_barrier()
#define PG8_SCHED __builtin_amdgcn_sched_barrier(0)
    Unit cur, nxt; int ui = 0;
    if (!S.next(0, cur)) return;
    f32x4 acc[2][2][4][2];
#pragma unroll
    for (int a = 0; a < 2; ++a)
#pragma unroll
        for (int b = 0; b < 2; ++b)
#pragma unroll
            for (int m = 0; m < 4; ++m)
#pragma unroll
                for (int n = 0; n < 2; ++n) acc[a][b][m][n] = (f32x4){0.f, 0.f, 0.f, 0.f};
    bf16x8 At[4][2], B0[2][2], B1[2][2];
    const char* cA = (const char*)g.A + (size_t)cur.pm * tstep; const char* cB = (const char*)g.Bt + (size_t)cur.pn * tstep;
    S.a_ready(cur);
    if constexpr (SP2) {
        PG8_STAGE(PG8_SB(0, 0), cB, voffB); PG8_STAGE(PG8_SB(0, 1), cB + hstep, voffB); PG8_STAGE(PG8_SA(0, 0), cA, voffA); PG8_STAGE(PG8_SA(0, 1), cA + hstep, voffA);
        if (wr == 1) PG8_BAR;
        PG8_WAIT_V(2); PG8_BAR;
        PG8_STAGE(PG8_SB(1, 0), cB + kstep, voffB); PG8_STAGE(PG8_SA(1, 0), cA + kstep, voffA); PG8_STAGE(PG8_SB(1, 1), cB + hstep + kstep, voffB);
        PG8_WAIT_V(6); PG8_BAR;
    } else {
        PG8_STAGE(PG8_SB(0, 0), cB, voffB); PG8_STAGE(PG8_SA(0, 0), cA, voffA); PG8_STAGE(PG8_SB(0, 1), cB + hstep, voffB); PG8_STAGE(PG8_SA(0, 1), cA + hstep, voffA);
        if (wr == 1) PG8_BAR;
        PG8_WAIT_V(4); PG8_BAR;
        PG8_STAGE(PG8_SB(1, 0), cB + kstep, voffB); PG8_STAGE(PG8_SA(1, 0), cA + kstep, voffA); PG8_STAGE(PG8_SB(1, 1), cB + hstep + kstep, voffB);
        PG8_WAIT_V(6); PG8_BAR;
    }
    for (;;) {
        const bool has_next = S.next(ui + 1, nxt);
        const char* nA = has_next ? (const char*)g.A + (size_t)nxt.pm * tstep : cA; const char* nB = has_next ? (const char*)g.Bt + (size_t)nxt.pn * tstep : cB;
        for (int t = 0; t < nt; t += 2) {
            const bool last = (t == nt - 2);
            const char* a1 = cA + (size_t)(t + 1) * kstep;
            const char* a2 = last ? nA : cA + (size_t)(t + 2) * kstep; const char* b2 = last ? nB : cB + (size_t)(t + 2) * kstep;
            const char* a3 = a2 + kstep; const char* b3 = b2 + kstep;
            if (last && has_next) S.a_ready(nxt);
            if constexpr (SP2) {
            PG8_LDB(B0, 0, 0); PG8_LDB(B1, 0, 1); PG8_SCHED; PG8_LDA(At, 0, 0); PG8_STAGE(PG8_SA(1, 1), a1 + hstep, voffA);
            PG8_WAIT_V(8); PG8_WAIT_L(0); PG8_BAR; PG8_MMA(0, 0, At, B0); PG8_MMA(0, 1, At, B1); PG8_BAR; PG8_SCHED;
            PG8_LDA(At, 0, 1); PG8_STAGE(PG8_SB(0, 0), b2, voffB); PG8_STAGE(PG8_SB(0, 1), b2 + hstep, voffB); PG8_STAGE(PG8_SA(0, 0), a2, voffA);
            PG8_WAIT_V(8); PG8_WAIT_L(0); PG8_BAR; PG8_MMA(1, 0, At, B0); PG8_MMA(1, 1, At, B1); PG8_BAR; PG8_SCHED;
            PG8_LDB(B0, 1, 0); PG8_LDB(B1, 1, 1); PG8_SCHED; PG8_LDA(At, 1, 0); PG8_STAGE(PG8_SA(0, 1), a2 + hstep, voffA);
            PG8_WAIT_V(8); PG8_WAIT_L(0); PG8_BAR; PG8_MMA(0, 0, At, B0); PG8_MMA(0, 1, At, B1); PG8_BAR; PG8_SCHED;
            PG8_LDA(At, 1, 1); PG8_STAGE(PG8_SB(1, 0), b3, voffB); PG8_STAGE(PG8_SB(1, 1), b3 + hstep, voffB); PG8_STAGE(PG8_SA(1, 0), a3, voffA);
            PG8_WAIT_V(8); PG8_WAIT_L(0); PG8_BAR; PG8_MMA(1, 0, At, B0); PG8_MMA(1, 1, At, B1); PG8_BAR; PG8_SCHED;
            } else {
            PG8_LDB(B0, 0, 0); PG8_SCHED; PG8_LDA(At, 0, 0); PG8_STAGE(PG8_SA(1, 1), a1 + hstep, voffA);
            PG8_WAIT_L(8); PG8_BAR; PG8_WAIT_L(0); PG8_MMA(0, 0, At, B0); PG8_BAR; PG8_SCHED;
            PG8_LDB(B1, 0, 1); PG8_STAGE(PG8_SB(0, 0), b2, voffB);
            PG8_BAR; PG8_WAIT_L(0); PG8_MMA(0, 1, At, B1); PG8_BAR;
            PG8_LDA(At, 0, 1); PG8_STAGE(PG8_SA(0, 0), a2, voffA);
            PG8_BAR; PG8_WAIT_L(0); PG8_MMA(1, 0, At, B0); PG8_BAR; PG8_SCHED;
            PG8_STAGE(PG8_SB(0, 1), b2 + hstep, voffB);
            PG8_WAIT_V(6); PG8_BAR; PG8_MMA(1, 1, At, B1); PG8_BAR;
            PG8_LDB(B0, 1, 0); PG8_SCHED; PG8_LDA(At, 1, 0); PG8_STAGE(PG8_SA(0, 1), a2 + hstep, voffA);
            PG8_WAIT_L(8); PG8_BAR; PG8_WAIT_L(0); PG8_MMA(0, 0, At, B0); PG8_BAR; PG8_SCHED;
            PG8_LDB(B1, 1, 1); PG8_STAGE(PG8_SB(1, 0), b3, voffB);
            PG8_BAR; PG8_WAIT_L(0); PG8_MMA(0, 1, At, B1); PG8_BAR;
            PG8_LDA(At, 1, 1); PG8_STAGE(PG8_SA(1, 0), a3, voffA);
            PG8_BAR; PG8_WAIT_L(0); PG8_MMA(1, 0, At, B0); PG8_BAR; PG8_SCHED;
            PG8_STAGE(PG8_SB(1, 1), b3 + hstep, voffB);
            PG8_WAIT_V(6); PG8_BAR; PG8_MMA(1, 1, At, B1); PG8_BAR;
            }
        }
        if constexpr (ALIGN_EPI) { if (wr == 0) PG8_BAR; }
        if constexpr (!Epi::AFTER_DRAIN) { E(acc, cur, wr, wc, fr, fq); S.done(cur); }
        if (!has_next) break;
#pragma unroll
        for (int a = 0; a < 2; ++a)
#pragma unroll
            for (int b = 0; b < 2; ++b)
#pragma unroll
                for (int m = 0; m < 4; ++m)
#pragma unroll
                    for (int n = 0; n < 2; ++n) acc[a][b][m][n] = (f32x4){0.f, 0.f, 0.f, 0.f};
        cur = nxt; cA = nA; cB = nB; ++ui;
        if constexpr (ALIGN_EPI) { if (wr == 1) PG8_BAR; }
    }
    PG8_WAIT_V(0);
    if constexpr (!ALIGN_EPI) { if (wr == 0) PG8_BAR; }
    PG8_BAR;
    if constexpr (Epi::AFTER_DRAIN) { E.fused(acc, cur, wr, wc, fr, fq, lds, wid, lane); S.done(cur); }
#undef PG8_SA
#undef PG8_SB
#undef PG8_STAGE
#undef PG8_LDA
#undef PG8_LDB
#undef PG8_MMA
#undef PG8_WAIT_V
#undef PG8_WAIT_L
#undef PG8_BAR
#undef PG8_SCHED
}
}

#ifndef PG8_SP2
#define PG8_SP2 true
#endif
#ifndef PG8_ALIGN
#define PG8_ALIGN true
#endif

constexpr int NWAVES = 8;
constexpr int D = 1024, DR = 1408, DFF = 2816, NBATCH = 8, SEQ = 2048, NMETA = 16, NSMP = 128;
constexpr int LRU_BW = 88;
constexpr int MROWS = 16640;
constexpr int R_META = 16384, R_SMP = 16400, R_END = 16528;
constexpr int S5_RB = 1160;
constexpr float RMS_EPS = 1e-6f;
constexpr size_t O_YP = 0, O_YS = 16777216, O_LHP = 16908288, O_LCP = 16919552, O_SRP = 16953344, O_SIP = 16986112,
                 O_LHS = 17018880, O_LCS = 17199104, O_SRS = 17739776, O_SIS = 18264064, O_END = 18788352;
constexpr size_t al256(size_t x) { return (x + 255) & ~(size_t)255; }
constexpr size_t WS_CTL = 0, CTL_ZERO_BYTES = 1u << 20;
constexpr size_t WS_W1T = CTL_ZERO_BYTES;
constexpr size_t WS_W2T = WS_W1T + (size_t)2816 * 1024 * 2;
constexpr size_t WS_W3T = WS_W2T + (size_t)1024 * 1408 * 2;
constexpr size_t WS_W4T = WS_W3T + (size_t)2 * 5632 * 1024 * 2;
constexpr size_t WS_W5T = WS_W4T + (size_t)2 * 1024 * 2816 * 2;
constexpr size_t WS_WGT = WS_W5T + (size_t)2048 * 1024 * 2;
constexpr size_t WS_S5WE = WS_WGT + (size_t)16 * 2 * 96 * 96 * 2;
constexpr size_t WS_S5WY = WS_S5WE + (size_t)64 * 128 * 256 * 2;
constexpr size_t WS_S5C = WS_S5WY + (size_t)64 * 256 * 384 * 2;
constexpr size_t WS_XEX = WS_S5C + (size_t)6 * 4096 * 4;
constexpr size_t WS_XN = WS_XEX + (size_t)256 * 1024 * 4;
constexpr size_t WS_R1 = WS_XN + (size_t)MROWS * 1024 * 2;
constexpr size_t WS_R2 = WS_R1 + (size_t)MROWS * 2816 * 2;
constexpr size_t WS_END = WS_R2 + (size_t)MROWS * 1408 * 2;
static_assert(WS_END <= (size_t)268435456, "d_ws map exceeds 256 MiB");
static_assert((WS_W1T % 256) == 0 && (WS_W2T % 256) == 0 && (WS_W3T % 256) == 0 && (WS_W4T % 256) == 0 && (WS_W5T % 256) == 0 && (WS_WGT % 256) == 0 && (WS_S5WE % 256) == 0 &&
              (WS_S5WY % 256) == 0 && (WS_S5C % 256) == 0 && (WS_XEX % 256) == 0 && (WS_XN % 256) == 0 && (WS_R1 % 256) == 0 && (WS_R2 % 256) == 0, "alignment");
constexpr int CW_BAR = 4096;
constexpr int RING_OFF = 0, RING_BYTES = 131072;
constexpr int LDSCTL_OFF = RING_BYTES, MISC_OFF = LDSCTL_OFF + 320;
constexpr int LDS_BYTES = 147456;

#define GAS __attribute__((address_space(1)))
#define LAS __attribute__((address_space(3)))
typedef unsigned short bf16;
typedef unsigned v4u __attribute__((ext_vector_type(4)));
typedef unsigned v2u __attribute__((ext_vector_type(2)));
typedef float f32x4 __attribute__((ext_vector_type(4)));
typedef short bf16x8 __attribute__((ext_vector_type(8)));
typedef GAS unsigned gu32;
#define LDS_WAIT() asm volatile("s_waitcnt lgkmcnt(0)" ::: "memory")
#define VM_WAIT() asm volatile("s_waitcnt vmcnt(0)" ::: "memory")
__device__ __forceinline__ unsigned f2bf(float f) { unsigned u = __builtin_bit_cast(unsigned, f); return (u + 0x7fffu + ((u >> 16) & 1u)) >> 16; }
__device__ __forceinline__ unsigned pk2(float lo, float hi) { return f2bf(lo) | (f2bf(hi) << 16); }
__device__ __forceinline__ float bf2f(unsigned short b) { return __builtin_bit_cast(float, (unsigned)b << 16); }
__device__ __forceinline__ float bflo(unsigned w) { return __builtin_bit_cast(float, w << 16); }
__device__ __forceinline__ float bfhi(unsigned w) { return __builtin_bit_cast(float, w & 0xffff0000u); }
__device__ __forceinline__ float wave_sum(float v) {
#pragma unroll
    for (int o = 1; o < 64; o <<= 1) v += __shfl_xor(v, o);
    return v;
}
using pg8::gelu_tanh_f; using pg8::sigmoid_f;

#define XB_TMO      128
#define XB_XCNT(j)  (256  + 64 * (j))
#define XB_XSUB(j)  (1280 + 64 * (j))
#define XB_XGEN(j)  (2304 + 64 * (j))
#define XB_TOP      3328
#define XB_TOPGEN   3392
#define XCD_BAR_WORDS 3456
#define XB_SPIN_CAP (1u << 18)

__device__ __forceinline__ unsigned xb_ld(unsigned* p)              { return __hip_atomic_load(p, __ATOMIC_RELAXED, __HIP_MEMORY_SCOPE_AGENT); }
__device__ __forceinline__ unsigned xb_add(unsigned* p, unsigned v) { return __hip_atomic_fetch_add(p, v, __ATOMIC_RELAXED, __HIP_MEMORY_SCOPE_AGENT); }
__device__ __forceinline__ unsigned xb_xcc_id() { return (unsigned)__builtin_amdgcn_s_getreg((3 << 11) | 20) & 0xFu; }
#define XB_SPIN(cond, bar) do { unsigned _sp = 0; while (cond) { __builtin_amdgcn_s_sleep(1); \
    if ((++_sp & 255u) == 0u) { if (xb_ld(&(bar)[XB_TMO])) break; if (_sp > XB_SPIN_CAP) { atomicAdd(&(bar)[XB_TMO], 1u); break; } } } } while (0)

struct XcdBarrier {
    unsigned* bar; unsigned x;
    volatile LAS unsigned* st;
};

__device__ __forceinline__ XcdBarrier xcd_barrier_post(unsigned* bar, volatile LAS unsigned* st) {
    XcdBarrier b; b.bar = bar; b.x = xb_xcc_id(); b.st = st;
    if (threadIdx.x == 0) (void)xb_add(&bar[XB_XCNT(b.x)], 1u);
    return b;
}
__device__ __forceinline__ void xcd_barrier_complete(unsigned* bar, unsigned x, unsigned& nloc, unsigned& nx) {
    const unsigned G = gridDim.x * gridDim.y * gridDim.z;
    unsigned sum, cnt, mine, sp = 0u;
    for (;;) {
        sum = 0u; cnt = 0u; mine = 0u;
#pragma unroll
        for (unsigned j = 0; j < 16; ++j) { const unsigned c = xb_ld(&bar[XB_XCNT(j)]); sum += c; cnt += (c > 0u) ? 1u : 0u; mine = (j == x) ? c : mine; }
        if (sum == G) break;
        __builtin_amdgcn_s_sleep(1);
        if ((++sp & 255u) == 0u) { if (xb_ld(&bar[XB_TMO])) break; if (sp > XB_SPIN_CAP) { atomicAdd(&bar[XB_TMO], 1u); break; } }
    }
    nloc = mine > 0u ? mine : 1u; nx = cnt > 0u ? cnt : 1u;
}

__device__ __forceinline__ void xcd_barrier(const XcdBarrier& b) {
    asm volatile("s_waitcnt vmcnt(0)" ::: "memory");
    __syncthreads();
    if (threadIdx.x == 0) {
        unsigned* bar = b.bar;
        __builtin_amdgcn_s_waitcnt(0);
        unsigned nloc = b.st[0], nx = b.st[1];
        if (nloc == 0u) { xcd_barrier_complete(bar, b.x, nloc, nx); b.st[0] = nloc; b.st[1] = nx; }
        const unsigned old = xb_add(&bar[XB_XSUB(b.x)], 1u);
        const unsigned gen = old / nloc;
        if (old + 1u == (gen + 1u) * nloc) {
            __builtin_amdgcn_fence(__ATOMIC_RELEASE, "agent");
            asm volatile("s_waitcnt vmcnt(0)" ::: "memory");
            const unsigned og = xb_add(&bar[XB_TOP], 1u);
            const unsigned tg = og / nx;
            if (og + 1u == (tg + 1u) * nx) xb_add(&bar[XB_TOPGEN], 1u);
            else XB_SPIN(xb_ld(&bar[XB_TOPGEN]) == tg, bar);
            __builtin_amdgcn_fence(__ATOMIC_ACQUIRE, "agent");
            xb_add(&bar[XB_XGEN(b.x)], 1u);
            asm volatile("s_waitcnt vmcnt(0)" ::: "memory");
        } else {
            XB_SPIN(xb_ld(&bar[XB_XGEN(b.x)]) == gen, bar);
            __builtin_amdgcn_fence(__ATOMIC_ACQUIRE, "agent");
            asm volatile("s_waitcnt vmcnt(0)" ::: "memory");
        }
    }
    __syncthreads();
}

struct Args { const float* in[28]; float* out; unsigned char* ws; int ph_lo, ph_hi; };
enum { I_XP = 0, I_XS, I_LH, I_LC, I_SRE, I_SIM, I_META, I_GAIN, I_LWIN, I_LWCONV, I_LBCONV, I_LWA, I_LBA, I_LWX, I_LBX, I_LLAM, I_LWOUT,
       I_SLRE, I_SLIM, I_SLDT, I_SBRE, I_SBIM, I_SCRE, I_SCIM, I_SD, I_SWOUT, I_FWIN, I_FWOUT };

struct Ctx {
    LAS unsigned char* lds;
    int tid, lane, wave, vcu, G;
    const float* const* in; float* out; unsigned char* ws;
};

__device__ __forceinline__ void transpose_item(const float* W, int K, int N, bf16* WT, int half, LAS float* scr, int item, int lane) {
    const int nblk = N / 32, kb = item / nblk, nb = item % nblk, k0 = 64 * kb, n0 = 32 * nb;
    int r0 = n0;
    if (half) { const int c = n0 < half ? n0 : n0 - half; r0 = 256 * (c >> 7) + (c & 127) + (n0 < half ? 0 : 128); }
#pragma unroll 8
    for (int i = 0; i < 32; ++i) { const int kk = 2 * i + (lane >> 5); scr[kk * 33 + (lane & 31)] = W[(size_t)(k0 + kk) * N + n0 + (lane & 31)]; }
    LDS_WAIT(); asm volatile("" ::: "memory");
    const int c = lane & 7;
#pragma unroll
    for (int j = 0; j < 4; ++j) { const int n = (lane >> 3) + 8 * j; const LAS float* s = scr + (8 * c) * 33 + n;
        v4u o; o.x = pk2(s[0 * 33], s[1 * 33]); o.y = pk2(s[2 * 33], s[3 * 33]); o.z = pk2(s[4 * 33], s[5 * 33]); o.w = pk2(s[6 * 33], s[7 * 33]);
        *(GAS v4u*)(WT + (size_t)(r0 + n) * K + k0 + 8 * c) = o; }
    LDS_WAIT(); asm volatile("" ::: "memory");
}
__device__ __forceinline__ const float* x0_row(const Ctx& C, int r) {
    if (r < R_META) return C.in[I_XP] + (size_t)r * D;
    if (r < R_SMP) return C.in[I_META] + (size_t)(r - R_META) * D;
    return C.in[I_XS] + (size_t)(r - R_SMP) * D;
}
__device__ __forceinline__ float* xs_row(const Ctx& C, int r) {
    if (r < R_META) return C.out + O_YP + (size_t)r * D;
    return (float*)(C.ws + WS_XEX) + (size_t)(r - R_META) * D;
}
__device__ __forceinline__ float sin2pi(float turns) { return __builtin_amdgcn_sinf(turns - rintf(turns)); }
__device__ __forceinline__ float cos2pi(float turns) { return __builtin_amdgcn_cosf(turns - rintf(turns)); }

__device__ __forceinline__ void s5_prep_group(const Ctx& C, int g) {
    LAS float* PWr = (LAS float*)(C.lds + RING_OFF);
    LAS float* PWi = PWr + 17 * 64;
    LAS float* BBr = PWi + 17 * 64;
    LAS float* BBi = BBr + 1024;
    LAS float* Cr = BBi + 1024;
    LAS float* Ci = Cr + 1024;
    LAS float* KT = Ci + 1024;
    const int tid = C.tid;
    const float INV2PI = 0.15915494309189535f;
    if (tid < 64) {
        const int p = tid;
        const float dt = expf(C.in[I_SLDT][g]);
        const float lr = C.in[I_SLRE][g * 64 + p], li = C.in[I_SLIM][g * 64 + p];
        const float x = dt * lr, y = dt * li, yt = y * INV2PI;
        for (int tau = 0; tau <= 16; ++tau) { const float mag = expf((float)tau * x), tr = (float)tau * yt;
            PWr[tau * 64 + p] = mag * cos2pi(tr); PWi[tau * 64 + p] = mag * sin2pi(tr); }
        const float em1 = expm1f(x), cy = cos2pi(yt), sy = sin2pi(yt), sh = sin2pi(0.5f * yt), cm1 = -2.0f * sh * sh;
        const float ar = em1 * cy + cm1, ai = (em1 + 1.0f) * sy;
        const float den = 1.0f / (lr * lr + li * li);
        const float qr = (ar * lr + ai * li) * den, qi = (ai * lr - ar * li) * den;
        for (int c = 0; c < 16; ++c) { const float br = C.in[I_SBRE][(size_t)(g * 64 + p) * 16 + c], bi = C.in[I_SBIM][(size_t)(g * 64 + p) * 16 + c];
            BBr[p * 16 + c] = qr * br - qi * bi; BBi[p * 16 + c] = qr * bi + qi * br; }
        float* S5C = (float*)(C.ws + WS_S5C);
        S5C[0 * 4096 + g * 64 + p] = PWr[16 * 64 + p]; S5C[1 * 4096 + g * 64 + p] = PWi[16 * 64 + p];
        S5C[2 * 4096 + g * 64 + p] = PWr[1 * 64 + p];  S5C[3 * 4096 + g * 64 + p] = PWi[1 * 64 + p];
        const float mag = expf(-15.0f * x), tr = -15.0f * yt;
        S5C[4 * 4096 + g * 64 + p] = mag * cos2pi(tr); S5C[5 * 4096 + g * 64 + p] = mag * sin2pi(tr);
    }
    for (int i = tid; i < 1024; i += 512) { Cr[i] = C.in[I_SCRE][(size_t)g * 1024 + i]; Ci[i] = C.in[I_SCIM][(size_t)g * 1024 + i]; }
    __syncthreads();
    for (int e = tid; e < 4096; e += 512) { const int tau = e >> 8, co = (e >> 4) & 15, ci = e & 15; float acc = 0.f;
        for (int p = 0; p < 64; ++p) { const float pr = PWr[tau * 64 + p], pi = PWi[tau * 64 + p], br = BBr[p * 16 + ci], bi = BBi[p * 16 + ci];
            const float tr = pr * br - pi * bi, ti = pr * bi + pi * br; acc += Cr[co * 64 + p] * tr - Ci[co * 64 + p] * ti; }
        KT[e] = acc; }
    __syncthreads();
    bf16* WY = (bf16*)(C.ws + WS_S5WY) + (size_t)g * 256 * 384;
    for (int e = tid; e < 256 * 48; e += 512) { const int n = e / 48, kg = e % 48, t = n >> 4, co = n & 15; float v[8];
#pragma unroll
        for (int q = 0; q < 8; ++q) { const int k = kg * 8 + q; float val;
            if (k < 256) { const int s = k >> 4, ci = k & 15; val = (s <= t) ? KT[(t - s) * 256 + co * 16 + ci] : 0.f; }
            else if (k < 320) { const int p = k - 256; val = Cr[co * 64 + p] * PWr[(t + 1) * 64 + p] - Ci[co * 64 + p] * PWi[(t + 1) * 64 + p]; }
            else { const int p = k - 320; val = -(Cr[co * 64 + p] * PWi[(t + 1) * 64 + p] + Ci[co * 64 + p] * PWr[(t + 1) * 64 + p]); }
            v[q] = val; }
        v4u o; o.x = pk2(v[0], v[1]); o.y = pk2(v[2], v[3]); o.z = pk2(v[4], v[5]); o.w = pk2(v[6], v[7]);
        *(GAS v4u*)(WY + (size_t)n * 384 + kg * 8) = o; }
    bf16* WE = (bf16*)(C.ws + WS_S5WE) + (size_t)g * 128 * 256;
    for (int e = tid; e < 128 * 32; e += 512) { const int n = e >> 5, kg = e & 31, p = n & 63, im = n >> 6; float v[8];
#pragma unroll
        for (int q = 0; q < 8; ++q) { const int k = kg * 8 + q, s = k >> 4, ci = k & 15;
            const float pr = PWr[(15 - s) * 64 + p], pi = PWi[(15 - s) * 64 + p], br = BBr[p * 16 + ci], bi = BBi[p * 16 + ci];
            v[q] = im ? (pr * bi + pi * br) : (pr * br - pi * bi); }
        v4u o; o.x = pk2(v[0], v[1]); o.y = pk2(v[2], v[3]); o.z = pk2(v[4], v[5]); o.w = pk2(v[6], v[7]);
        *(GAS v4u*)(WE + (size_t)n * 256 + kg * 8) = o; }
    __syncthreads();
}

__device__ __forceinline__ void p0_prologue(const Ctx& C) {
    if (C.vcu < 64) s5_prep_group(C, C.vcu);
    LAS float* scr = (LAS float*)(C.lds + RING_OFF + C.wave * 16384);
    const int gw = C.vcu * NWAVES + C.wave, NGW = C.G * NWAVES;
    constexpr int I_1 = (1024 / 64) * (2816 / 32), I_2 = (1408 / 64) * (1024 / 32), I_3 = (1024 / 64) * (5632 / 32), I_4 = (2816 / 64) * (1024 / 32), I_5 = (1024 / 64) * (2048 / 32);
    constexpr int NITEMS = I_1 + I_2 + 2 * I_3 + 2 * I_4 + I_5;
    for (int it = gw; it < NITEMS; it += NGW) {
        int r = it;
        if (r < I_1) { transpose_item(C.in[I_LWIN], 1024, 2816, (bf16*)(C.ws + WS_W1T), 0, scr, r, C.lane); continue; } r -= I_1;
        if (r < I_2) { transpose_item(C.in[I_LWOUT], 1408, 1024, (bf16*)(C.ws + WS_W2T), 0, scr, r, C.lane); continue; } r -= I_2;
        if (r < I_3) { transpose_item(C.in[I_FWIN], 1024, 5632, (bf16*)(C.ws + WS_W3T), 2816, scr, r, C.lane); continue; } r -= I_3;
        if (r < I_3) { transpose_item(C.in[I_FWIN] + (size_t)1024 * 5632, 1024, 5632, (bf16*)(C.ws + WS_W3T) + (size_t)5632 * 1024, 2816, scr, r, C.lane); continue; } r -= I_3;
        if (r < I_4) { transpose_item(C.in[I_FWOUT], 2816, 1024, (bf16*)(C.ws + WS_W4T), 0, scr, r, C.lane); continue; } r -= I_4;
        if (r < I_4) { transpose_item(C.in[I_FWOUT] + (size_t)2816 * 1024, 2816, 1024, (bf16*)(C.ws + WS_W4T) + (size_t)1024 * 2816, 0, scr, r, C.lane); continue; } r -= I_4;
        transpose_item(C.in[I_SWOUT], 1024, 2048, (bf16*)(C.ws + WS_W5T), 1024, scr, r, C.lane);
    }
    { bf16* WG = (bf16*)(C.ws + WS_WGT); const int gt = (C.vcu * NWAVES + C.wave) * 64 + C.lane, NT = C.G * 512;
      for (int e = gt; e < 16 * 2 * 96 * 96; e += NT) { const int i = e % 96, j = (e / 96) % 96, gate = (e / 9216) & 1, h = e / 18432;
          const float* wsel = gate ? C.in[I_LWX] : C.in[I_LWA]; float v = 0.f; if (i < 88 && j < 88) v = wsel[(size_t)(h * 88 + i) * 88 + j];
          WG[e] = (bf16)f2bf(v); } }
    { const float* gain = C.in[I_GAIN]; bf16* XN = (bf16*)(C.ws + WS_XN);
      for (int r = gw; r < R_END; r += NGW) {
          const GAS f32x4* xr = (const GAS f32x4*)x0_row(C, r) + C.lane; f32x4 v[4]; float s = 0.f;
#pragma unroll
          for (int j = 0; j < 4; ++j) { v[j] = xr[64 * j]; s += (v[j].x * v[j].x + v[j].y * v[j].y) + (v[j].z * v[j].z + v[j].w * v[j].w); }
          const float rs = rsqrtf(wave_sum(s) * (1.f / D) + RMS_EPS);
          GAS v2u* o8 = (GAS v2u*)(XN + (size_t)r * D) + C.lane;
#pragma unroll
          for (int j = 0; j < 4; ++j) { const f32x4 gg = *((const GAS f32x4*)gain + C.lane + 64 * j);
              v2u o; o.x = pk2(v[j].x * rs * gg.x, v[j].y * rs * gg.y); o.y = pk2(v[j].z * rs * gg.z, v[j].w * rs * gg.w); o8[64 * j] = o; } } }
}

template <int MODE>
__device__ __forceinline__ void nr_phase(const Ctx& C, const bf16* MB, const float* ga, const float* gb) {
    const int gw = C.vcu * NWAVES + C.wave, NGW = C.G * NWAVES, lane = C.lane;
    bf16* XN = (bf16*)(C.ws + WS_XN); bf16* XNS = (bf16*)(C.ws + WS_R1);
    for (int r = gw; r < R_END; r += NGW) {
        if (MODE == 3 && r >= R_META && r < R_SMP) continue;
        const float* xsrc = (MODE == 0) ? x0_row(C, r) : xs_row(C, r);
        float* xdst = (MODE == 3 && r >= R_SMP) ? C.out + O_YS + (size_t)(r - R_SMP) * D : xs_row(C, r);
        const GAS v2u* mr = (const GAS v2u*)(MB + (size_t)r * D) + lane;
        f32x4 m[4], x[4]; float s = 0.f;
#pragma unroll
        for (int j = 0; j < 4; ++j) { const v2u w = mr[64 * j]; m[j] = (f32x4){bflo(w.x), bfhi(w.x), bflo(w.y), bfhi(w.y)};
            x[j] = *((const GAS f32x4*)xsrc + lane + 64 * j);
            s += (m[j].x * m[j].x + m[j].y * m[j].y) + (m[j].z * m[j].z + m[j].w * m[j].w); }
        const float rs = rsqrtf(wave_sum(s) * (1.f / D) + RMS_EPS);
        float s2 = 0.f;
#pragma unroll
        for (int j = 0; j < 4; ++j) { const f32x4 gg = *((const GAS f32x4*)ga + lane + 64 * j);
            x[j] = x[j] + m[j] * rs * gg; s2 += (x[j].x * x[j].x + x[j].y * x[j].y) + (x[j].z * x[j].z + x[j].w * x[j].w);
            *((GAS f32x4*)xdst + lane + 64 * j) = x[j]; }
        if (MODE == 3) continue;
        const float rs2 = rsqrtf(wave_sum(s2) * (1.f / D) + RMS_EPS);
        v2u o[4];
#pragma unroll
        for (int j = 0; j < 4; ++j) { const f32x4 gg = *((const GAS f32x4*)gb + lane + 64 * j);
            o[j].x = pk2(x[j].x * rs2 * gg.x, x[j].y * rs2 * gg.y); o[j].y = pk2(x[j].z * rs2 * gg.z, x[j].w * rs2 * gg.w); }
        if (MODE == 1) {
            if (r < R_META) { const int b = r >> 11, jt = r & 2047, rb = b * 129 + 1 + (jt >> 4), s = jt & 15;
#pragma unroll
                for (int j = 0; j < 4; ++j) *(GAS v2u*)(XNS + (((size_t)rb * 64 + 16 * j + (lane >> 2)) * 16 + s) * 16 + 4 * (lane & 3)) = o[j]; }
            else if (r < R_SMP) { const int s = r - R_META;
                for (int b = 0; b < NBATCH; ++b)
#pragma unroll
                    for (int j = 0; j < 4; ++j) *(GAS v2u*)(XNS + (((size_t)(b * 129) * 64 + 16 * j + (lane >> 2)) * 16 + s) * 16 + 4 * (lane & 3)) = o[j]; }
            else { const int rb = 1032 + (r - R_SMP);
#pragma unroll
                for (int j = 0; j < 4; ++j) *(GAS v2u*)(XNS + (((size_t)rb * 64 + 16 * j + (lane >> 2)) * 16 + 0) * 16 + 4 * (lane & 3)) = o[j];
                GAS v2u* zb = (GAS v2u*)(XNS + (size_t)rb * 64 * 256);
                for (int e = lane; e < 64 * 60; e += 64) { const int g = e / 60, q = e % 60; zb[g * 64 + 4 + q] = (v2u){0u, 0u}; } }
        } else {
            GAS v2u* o8 = (GAS v2u*)(XN + (size_t)r * D) + lane;
#pragma unroll
            for (int j = 0; j < 4; ++j) o8[64 * j] = o[j];
        }
    }
}

constexpr int LRU_XB = 0, LRU_XCA = 12288, LRU_XCF = 25600;
struct LruLane { float ba, bx, sp8; int chl, ch; bool valid; bf16x8 bA[3], bX[3]; };

__device__ __forceinline__ void lru_lane_setup(const Ctx& C, int h, LruLane& L) {
    const int fr = C.lane & 15, fq = C.lane >> 4, wn = C.wave < 6 ? C.wave : 5;
    const int cl = 16 * wn + fr; L.chl = cl < 88 ? cl : 87; L.ch = 88 * h + L.chl; L.valid = (C.wave < 6) && (cl < 88);
    L.ba = C.in[I_LBA][L.ch]; L.bx = C.in[I_LBX][L.ch];
    const float lam = C.in[I_LLAM][L.ch]; L.sp8 = 8.0f * log1pf(expf(-lam));
    const bf16* WG = (const bf16*)(C.ws + WS_WGT);
#pragma unroll
    for (int ks = 0; ks < 3; ++ks) {
        L.bA[ks] = *(const GAS bf16x8*)(WG + ((size_t)(h * 2 + 0) * 96 + cl) * 96 + ks * 32 + fq * 8);
        L.bX[ks] = *(const GAS bf16x8*)(WG + ((size_t)(h * 2 + 1) * 96 + cl) * 96 + ks * 32 + fq * 8); }
}
__device__ __forceinline__ void lru_gates(const Ctx& C, const LruLane& L, int m, float (&av)[4], float (&bv)[4]) {
    const int fr = C.lane & 15, fq = C.lane >> 4;
    const LAS bf16* XCA = (const LAS bf16*)(C.lds + RING_OFF + LRU_XCA); const LAS float* XCF = (const LAS float*)(C.lds + RING_OFF + LRU_XCF);
    f32x4 accR = {0.f, 0.f, 0.f, 0.f}, accI = {0.f, 0.f, 0.f, 0.f};
#pragma unroll
    for (int ks = 0; ks < 3; ++ks) { const bf16x8 a = *(const LAS bf16x8*)(XCA + (16 * m + fr) * 104 + ks * 32 + fq * 8);
        accR = __builtin_amdgcn_mfma_f32_16x16x32_bf16(a, L.bA[ks], accR, 0, 0, 0);
        accI = __builtin_amdgcn_mfma_f32_16x16x32_bf16(a, L.bX[ks], accI, 0, 0, 0); }
#pragma unroll
    for (int j = 0; j < 4; ++j) { const int tl = 16 * m + 4 * fq + j; const float xc = XCF[tl * 96 + L.chl];
        const float r = sigmoid_f(accR[j] + L.ba), ig = sigmoid_f(accI[j] + L.bx);
        const float la = -L.sp8 * r;
        av[j] = __expf(la);
        const float om = -expm1f(2.0f * la);
        bv[j] = sqrtf(om > 0.f ? om : 0.f) * (ig * xc); }
}

__device__ __forceinline__ void lru_prompt_item(const Ctx& C, int b, int h) {
    const int tid = C.tid, lane = C.lane, fr = lane & 15, fq = lane >> 4, ch0 = 88 * h;
    LAS bf16* XB = (LAS bf16*)(C.lds + RING_OFF + LRU_XB); LAS bf16* XCA = (LAS bf16*)(C.lds + RING_OFF + LRU_XCA); LAS float* XCF = (LAS float*)(C.lds + RING_OFF + LRU_XCF);
    const bf16* XG = (const bf16*)(C.ws + WS_R1); bf16* A2 = (bf16*)(C.ws + WS_R2);
    const float* wconv = C.in[I_LWCONV]; const float* bconv = C.in[I_LBCONV];
    LruLane L; lru_lane_setup(C, h, L);
    __syncthreads();
    for (int e = tid; e < 64 * 16; e += 512) XCA[(e >> 4) * 104 + 88 + (e & 15)] = 0;
    float hc = 0.f;
    for (int c = 0; c < 33; ++c) {
        const int t0 = (c == 0) ? 0 : 16 + 64 * (c - 1), nt = (c == 0) ? 16 : 64;
        __syncthreads();
        for (int e = tid; e < (nt + 3) * 11; e += 512) { const int rr = e / 11, pc = e % 11, t = t0 + rr - 3; v4u v = {0u, 0u, 0u, 0u};
            if (t >= 0) { const size_t row = (t < NMETA) ? (size_t)(R_META + t) : (size_t)b * SEQ + (t - NMETA); v = *(const GAS v4u*)(XG + row * 2816 + ch0 + pc * 8); }
            *(LAS v4u*)(XB + rr * 88 + pc * 8) = v; }
        __syncthreads();
        for (int e = tid; e < nt * 88; e += 512) { const int tl = e / 88, i = e % 88; float acc = bconv[ch0 + i];
#pragma unroll
            for (int k = 0; k < 4; ++k) acc += wconv[k * DR + ch0 + i] * bf2f(XB[(tl + k) * 88 + i]);
            XCF[tl * 96 + i] = acc; XCA[tl * 104 + i] = (bf16)f2bf(acc); }
        __syncthreads();
        if (C.wave < 6) {
            const int nm = nt >> 4;
            for (int m = 0; m < nm; ++m) {
                float av[4], bv[4]; lru_gates(C, L, m, av, bv);
                float A_[4], B_[4]; A_[0] = av[0]; B_[0] = bv[0];
#pragma unroll
                for (int j = 1; j < 4; ++j) { A_[j] = av[j] * A_[j - 1]; B_[j] = av[j] * B_[j - 1] + bv[j]; }
                const float tA = A_[3], tB = B_[3];
                const float gA0 = __shfl(tA, fr), gB0 = __shfl(tB, fr), gA1 = __shfl(tA, fr + 16), gB1 = __shfl(tB, fr + 16);
                const float gA2 = __shfl(tA, fr + 32), gB2 = __shfl(tB, fr + 32), gA3 = __shfl(tA, fr + 48), gB3 = __shfl(tB, fr + 48);
                const float c2A = gA1 * gA0, c2B = gA1 * gB0 + gB1, c3A = gA2 * c2A, c3B = gA2 * c2B + gB2, tilA = gA3 * c3A, tilB = gA3 * c3B + gB3;
                const float cA = fq == 0 ? 1.f : (fq == 1 ? gA0 : (fq == 2 ? c2A : c3A)), cB = fq == 0 ? 0.f : (fq == 1 ? gB0 : (fq == 2 ? c2B : c3B));
                const float hb = cB + cA * hc;
#pragma unroll
                for (int j = 0; j < 4; ++j) { const float hj = B_[j] + A_[j] * hb; const int t = t0 + 16 * m + 4 * fq + j;
                    const size_t row = (t < NMETA) ? (size_t)(R_META + t) : (size_t)b * SEQ + (t - NMETA);
                    const float gg = bf2f(XG[row * 2816 + DR + L.ch]);
                    if (L.valid && (b == 0 || t >= NMETA)) A2[row * DR + L.ch] = (bf16)f2bf(hj * gg); }
                hc = tilB + tilA * hc;
            }
        }
    }
    if (L.valid && fq == 0) C.out[O_LHP + (size_t)b * DR + L.ch] = hc;
    if (tid < 3 * 88) { const int k = tid / 88, i = tid % 88;
        C.out[O_LCP + ((size_t)b * 3 + k) * DR + ch0 + i] = bf2f(XG[((size_t)b * SEQ + (SEQ - 3 + k)) * 2816 + ch0 + i]); }
}

__device__ __forceinline__ void lru_sample_item(const Ctx& C, int h) {
    const int tid = C.tid, lane = C.lane, fq = lane >> 4, ch0 = 88 * h;
    LAS bf16* XCA = (LAS bf16*)(C.lds + RING_OFF + LRU_XCA); LAS float* XCF = (LAS float*)(C.lds + RING_OFF + LRU_XCF);
    const bf16* XG = (const bf16*)(C.ws + WS_R1); bf16* A2 = (bf16*)(C.ws + WS_R2);
    const float* wconv = C.in[I_LWCONV]; const float* bconv = C.in[I_LBCONV]; const float* cs = C.in[I_LC]; const float* h0 = C.in[I_LH];
    LruLane L; lru_lane_setup(C, h, L);
    __syncthreads();
    for (int e = tid; e < 64 * 16; e += 512) XCA[(e >> 4) * 104 + 88 + (e & 15)] = 0;
    for (int c = 0; c < 2; ++c) {
        __syncthreads();
        for (int e = tid; e < 64 * 88; e += 512) { const int il = e / 88, i = e % 88, smp = 64 * c + il, ch = ch0 + i;
            const float xb = bf2f(XG[(size_t)(R_SMP + smp) * 2816 + ch]);
            const float c0 = cs[((size_t)smp * 3 + 0) * DR + ch], c1 = cs[((size_t)smp * 3 + 1) * DR + ch], c2 = cs[((size_t)smp * 3 + 2) * DR + ch];
            const float acc = bconv[ch] + wconv[0 * DR + ch] * c0 + wconv[1 * DR + ch] * c1 + wconv[2 * DR + ch] * c2 + wconv[3 * DR + ch] * xb;
            XCF[il * 96 + i] = acc; XCA[il * 104 + i] = (bf16)f2bf(acc);
            C.out[O_LCS + ((size_t)smp * 3 + 0) * DR + ch] = c1; C.out[O_LCS + ((size_t)smp * 3 + 1) * DR + ch] = c2; C.out[O_LCS + ((size_t)smp * 3 + 2) * DR + ch] = xb; }
        __syncthreads();
        if (C.wave < 6) {
            for (int m = 0; m < 4; ++m) {
                float av[4], bv[4]; lru_gates(C, L, m, av, bv);
#pragma unroll
                for (int j = 0; j < 4; ++j) { const int smp = 64 * c + 16 * m + 4 * fq + j; const size_t row = (size_t)(R_SMP + smp);
                    const float hn = av[j] * h0[(size_t)smp * DR + L.ch] + bv[j];
                    const float gg = bf2f(XG[row * 2816 + DR + L.ch]);
                    if (L.valid) { A2[row * DR + L.ch] = (bf16)f2bf(hn * gg); C.out[O_LHS + (size_t)smp * DR + L.ch] = hn; } }
            }
        }
    }
}

constexpr int S5_EB = 0, S5_HB = 76032;
__device__ __forceinline__ void s5_item(const Ctx& C, int it) {
    const int tid = C.tid, lane = C.lane, wave = C.wave, fr = lane & 15, fq = lane >> 4;
    const bool smp = it >= 512; const int g = smp ? it - 512 : (it & 63), b = smp ? 0 : (it >> 6);
    const int rb0 = smp ? 1032 : b * 129, nrow = smp ? 128 : 129, nm = smp ? 8 : 9;
    LAS float* EB = (LAS float*)(C.lds + RING_OFF + S5_EB); LAS bf16* HB = (LAS bf16*)(C.lds + RING_OFF + S5_HB);
    const bf16* U = (const bf16*)(C.ws + WS_R1) + ((size_t)rb0 * 64 + g) * 256;
    const bf16* WE = (const bf16*)(C.ws + WS_S5WE) + (size_t)g * 128 * 256; const bf16* WY = (const bf16*)(C.ws + WS_S5WY) + (size_t)g * 256 * 384;
    const float* S5C = (const float*)(C.ws + WS_S5C); bf16* Z = (bf16*)(C.ws + WS_R2);
    __syncthreads();
    { bf16x8 bE[8];
#pragma unroll
      for (int ks = 0; ks < 8; ++ks) bE[ks] = *(const GAS bf16x8*)(WE + (size_t)(16 * wave + fr) * 256 + ks * 32 + fq * 8);
      for (int m = 0; m < nm; ++m) { f32x4 acc = {0.f, 0.f, 0.f, 0.f}; const bf16* ar = U + (size_t)(16 * m + fr) * 16384 + fq * 8;
#pragma unroll
          for (int ks = 0; ks < 8; ++ks) { const bf16x8 a = *(const GAS bf16x8*)(ar + ks * 32); acc = __builtin_amdgcn_mfma_f32_16x16x32_bf16(a, bE[ks], acc, 0, 0, 0); }
#pragma unroll
          for (int j = 0; j < 4; ++j) EB[(16 * m + 4 * fq + j) * 132 + 16 * wave + fr] = acc[j]; } }
    __syncthreads();
    if (!smp) {
        if (wave == 0) { const int p = lane; const float ar = S5C[0 * 4096 + g * 64 + p], ai = S5C[1 * 4096 + g * 64 + p]; float hr = 0.f, hi = 0.f;
            for (int k0 = 0; k0 < 129; k0 += 8) { float er[8], ei[8];
#pragma unroll
                for (int q = 0; q < 8; ++q) { const int k = (k0 + q) < 129 ? (k0 + q) : 128; er[q] = EB[k * 132 + p]; ei[q] = EB[k * 132 + 64 + p]; }
#pragma unroll
                for (int q = 0; q < 8; ++q) { const int k = k0 + q; if (k < 129) { HB[k * 136 + p] = (bf16)f2bf(hr); HB[k * 136 + 64 + p] = (bf16)f2bf(hi);
                        const float nr = ar * hr - ai * hi + er[q], ni = ar * hi + ai * hr + ei[q]; hr = nr; hi = ni; } } }
            C.out[O_SRP + ((size_t)b * 64 + g) * 64 + p] = hr; C.out[O_SIP + ((size_t)b * 64 + g) * 64 + p] = hi; }
    } else {
        for (int e = tid; e < 128 * 64; e += 512) { const int i = e >> 6, p = e & 63;
            const float h0r = C.in[I_SRE][((size_t)i * 64 + g) * 64 + p], h0i = C.in[I_SIM][((size_t)i * 64 + g) * 64 + p];
            HB[i * 136 + p] = (bf16)f2bf(h0r); HB[i * 136 + 64 + p] = (bf16)f2bf(h0i);
            const float er = EB[i * 132 + p], ei = EB[i * 132 + 64 + p];
            const float a1r = S5C[2 * 4096 + g * 64 + p], a1i = S5C[3 * 4096 + g * 64 + p], mr = S5C[4 * 4096 + g * 64 + p], mi = S5C[5 * 4096 + g * 64 + p];
            C.out[O_SRS + ((size_t)i * 64 + g) * 64 + p] = a1r * h0r - a1i * h0i + (mr * er - mi * ei);
            C.out[O_SIS + ((size_t)i * 64 + g) * 64 + p] = a1r * h0i + a1i * h0r + (mr * ei + mi * er); }
    }
    __syncthreads();
    { bf16x8 bY[2][12];
#pragma unroll
      for (int nt = 0; nt < 2; ++nt)
#pragma unroll
          for (int ks = 0; ks < 12; ++ks) bY[nt][ks] = *(const GAS bf16x8*)(WY + (size_t)(16 * (2 * wave + nt) + fr) * 384 + ks * 32 + fq * 8);
      const float dsk = C.in[I_SD][16 * g + fr];
      for (int m = 0; m < nm; ++m) { f32x4 acc[2] = {{0.f, 0.f, 0.f, 0.f}, {0.f, 0.f, 0.f, 0.f}}; const bf16* ar = U + (size_t)(16 * m + fr) * 16384 + fq * 8;
#pragma unroll
          for (int ks = 0; ks < 12; ++ks) { bf16x8 a;
              if (ks < 8) a = *(const GAS bf16x8*)(ar + ks * 32); else a = *(const LAS bf16x8*)(HB + (16 * m + fr) * 136 + (ks - 8) * 32 + fq * 8);
              acc[0] = __builtin_amdgcn_mfma_f32_16x16x32_bf16(a, bY[0][ks], acc[0], 0, 0, 0);
              acc[1] = __builtin_amdgcn_mfma_f32_16x16x32_bf16(a, bY[1][ks], acc[1], 0, 0, 0); }
#pragma unroll
          for (int nt = 0; nt < 2; ++nt) { const int t = 2 * wave + nt;
#pragma unroll
              for (int j = 0; j < 4; ++j) { const int rl = 16 * m + 4 * fq + j;
                  if (rl < nrow) { const float xnv = bf2f(U[(size_t)rl * 16384 + t * 16 + fr]);
                      const float z = gelu_tanh_f(acc[nt][j] + dsk * xnv);
                      long row = -1;
                      if (smp) { if (t == 0) row = R_SMP + rl; }
                      else if (rl == 0) { if (b == 0) row = R_META + t; }
                      else row = (long)b * SEQ + 16 * (rl - 1) + t;
                      if (row >= 0) Z[(size_t)row * D + 16 * g + fr] = (bf16)f2bf(z); } } } } }
}

constexpr int N_PHASES = 14;
__global__ void __launch_bounds__(NWAVES * 64, 2) hybrid_fwd(Args args) {
    extern __shared__ __attribute__((aligned(16))) unsigned char lds_raw[];
    Ctx C;
    C.lds = (LAS unsigned char*)lds_raw;
    C.tid = threadIdx.x; C.lane = C.tid & 63; C.wave = __builtin_amdgcn_readfirstlane(C.tid >> 6);
    C.G = gridDim.x; { const int bx = blockIdx.x; C.vcu = (C.G % 8 == 0) ? (bx % 8) * (C.G / 8) + bx / 8 : bx; }
    C.in = args.in; C.out = args.out; C.ws = args.ws;
    volatile LAS unsigned* MISC = (volatile LAS unsigned*)(C.lds + MISC_OFF);
    for (int u = C.tid; u < (LDS_BYTES - LDSCTL_OFF) / 4; u += NWAVES * 64) ((LAS unsigned*)(C.lds + LDSCTL_OFF))[u] = 0u;
    __syncthreads();
    const int lo = args.ph_lo, hi = args.ph_hi;
    XcdBarrier bar; bar.bar = (unsigned*)(C.ws + WS_CTL) + CW_BAR; bar.x = 0; bar.st = nullptr;
    if (hi - lo > 1) bar = xcd_barrier_post((unsigned*)(C.ws + WS_CTL) + CW_BAR, MISC + 8);
#define IN(k) (lo <= (k) && (k) < hi)
#define SEAM(k) do { if (IN(k) && IN((k) + 1)) xcd_barrier(bar); } while (0)
    const float* gain = args.in[I_GAIN];
    bf16* XN = (bf16*)(C.ws + WS_XN); bf16* R1 = (bf16*)(C.ws + WS_R1); bf16* R2 = (bf16*)(C.ws + WS_R2);

    if (IN(0)) { p0_prologue(C); } SEAM(0);
    if (IN(1)) {
        pg8::Gemm g{XN, (const bf16*)(C.ws + WS_W1T), MROWS, 2816, 1024}; pg8::StaticOrder S; S.init(MROWS, 2816, C.G, (int)blockIdx.x);
        pg8::EpiXG E{R1};
        pg8::gemm_phase<pg8::EpiXG, pg8::StaticOrder, PG8_ALIGN, PG8_SP2>(C.lds + RING_OFF, g, S, E);
    } SEAM(1);
    if (IN(2)) {
        if (C.vcu < 128) lru_prompt_item(C, C.vcu >> 4, C.vcu & 15);
        else if (C.vcu < 144) lru_sample_item(C, C.vcu - 128);
    } SEAM(2);
    if (IN(3)) {
        pg8::Gemm g{R2, (const bf16*)(C.ws + WS_W2T), MROWS, 1024, 1408}; pg8::StaticOrder S; S.init(MROWS, 1024, C.G, (int)blockIdx.x);
        pg8::EpiPlain E{R1, 1024};
        pg8::gemm_phase<pg8::EpiPlain, pg8::StaticOrder, PG8_ALIGN, PG8_SP2>(C.lds + RING_OFF, g, S, E);
    } SEAM(3);
    if (IN(4)) { nr_phase<0>(C, R1, gain + 1 * D, gain + 2 * D); } SEAM(4);
    if (IN(5)) {
        pg8::Gemm g{XN, (const bf16*)(C.ws + WS_W3T), MROWS, 5632, 1024}; pg8::StaticOrder S; S.init(MROWS, 5632, C.G, (int)blockIdx.x);
        pg8::EpiGated<0> E{R1, 2816};
        pg8::gemm_phase<pg8::EpiGated<0>, pg8::StaticOrder, PG8_ALIGN, PG8_SP2>(C.lds + RING_OFF, g, S, E);
    } SEAM(5);
    if (IN(6)) {
        pg8::Gemm g{R1, (const bf16*)(C.ws + WS_W4T), MROWS, 1024, 2816}; pg8::StaticOrder S; S.init(MROWS, 1024, C.G, (int)blockIdx.x);
        pg8::EpiPlain E{R2, 1024};
        pg8::gemm_phase<pg8::EpiPlain, pg8::StaticOrder, PG8_ALIGN, PG8_SP2>(C.lds + RING_OFF, g, S, E);
    } SEAM(6);
    if (IN(7)) { nr_phase<1>(C, R2, gain + 3 * D, gain + 4 * D); } SEAM(7);
    if (IN(8)) {
        for (int it = C.vcu; it < 576; it += C.G) s5_item(C, it);
    } SEAM(8);
    if (IN(9)) {
        pg8::Gemm g{R2, (const bf16*)(C.ws + WS_W5T), MROWS, 2048, 1024}; pg8::StaticOrder S; S.init(MROWS, 2048, C.G, (int)blockIdx.x);
        pg8::EpiGated<1> E{R1, 1024};
        pg8::gemm_phase<pg8::EpiGated<1>, pg8::StaticOrder, PG8_ALIGN, PG8_SP2>(C.lds + RING_OFF, g, S, E);
    } SEAM(9);
    if (IN(10)) { nr_phase<2>(C, R1, gain + 5 * D, gain + 6 * D); } SEAM(10);
    if (IN(11)) {
        pg8::Gemm g{XN, (const bf16*)(C.ws + WS_W3T) + (size_t)5632 * 1024, MROWS, 5632, 1024}; pg8::StaticOrder S; S.init(MROWS, 5632, C.G, (int)blockIdx.x);
        pg8::EpiGated<0> E{R1, 2816};
        pg8::gemm_phase<pg8::EpiGated<0>, pg8::StaticOrder, PG8_ALIGN, PG8_SP2>(C.lds + RING_OFF, g, S, E);
    } SEAM(11);
    if (IN(12)) {
        pg8::Gemm g{R1, (const bf16*)(C.ws + WS_W4T) + (size_t)1024 * 2816, MROWS, 1024, 2816}; pg8::StaticOrder S; S.init(MROWS, 1024, C.G, (int)blockIdx.x);
        pg8::EpiPlain E{R2, 1024};
        pg8::gemm_phase<pg8::EpiPlain, pg8::StaticOrder, PG8_ALIGN, PG8_SP2>(C.lds + RING_OFF, g, S, E);
    } SEAM(12);
    if (IN(13)) { nr_phase<3>(C, R2, gain + 7 * D, gain); }
#undef IN
#undef SEAM
}

#ifndef MK_ONE_LAUNCH
#define MK_ONE_LAUNCH 1
#endif
extern "C" void kernel_launch(void* const* d_in, const int* in_sizes, int n_in, void* d_out, int out_size, void* d_ws, size_t ws_size, hipStream_t stream) {
    static int grid = 0;
    if (grid == 0) {
        if (n_in != 28 || out_size != (int)O_END || ws_size < WS_END) { fprintf(stderr, "kernel_launch: unexpected shapes: n_in %d out %d ws %zu (need %zu)\n", n_in, out_size, ws_size, (size_t)WS_END); grid = -1; return; }
        int dev = 0, cus = 0, per_cu = 0;
        if (hipGetDevice(&dev) != hipSuccess || hipDeviceGetAttribute(&cus, hipDeviceAttributeMultiprocessorCount, dev) != hipSuccess) { grid = -1; return; }
        if (hipFuncSetAttribute((const void*)hybrid_fwd, hipFuncAttributeMaxDynamicSharedMemorySize, LDS_BYTES) != hipSuccess) { fprintf(stderr, "kernel_launch: hipFuncSetAttribute failed\n"); grid = -1; return; }
        if (hipOccupancyMaxActiveBlocksPerMultiprocessor(&per_cu, (const void*)hybrid_fwd, NWAVES * 64, LDS_BYTES) != hipSuccess || per_cu < 1) { fprintf(stderr, "kernel_launch: occupancy query says %d\n", per_cu); }
        (void)hipGetLastError();
        grid = cus;
        if (grid != 256) fprintf(stderr, "kernel_launch: %d CUs (built for 256)\n", grid);
    }
    if (grid < 0) return;
    (void)in_sizes;
    if (hipMemsetAsync((char*)d_ws + WS_CTL, 0, CTL_ZERO_BYTES, stream) != hipSuccess) return;
    Args a{};
    for (int i = 0; i < 28; ++i) a.in[i] = (const float*)d_in[i];
    a.out = (float*)d_out; a.ws = (unsigned char*)d_ws;
#if MK_ONE_LAUNCH
    a.ph_lo = 0; a.ph_hi = N_PHASES;
    hipLaunchKernelGGL(hybrid_fwd, dim3(grid), dim3(NWAVES * 64), LDS_BYTES, stream, a);
#else
    for (int p = 0; p < N_PHASES; ++p) { a.ph_lo = p; a.ph_hi = p + 1;
        hipLaunchKernelGGL(hybrid_fwd, dim3(grid), dim3(NWAVES * 64), LDS_BYTES, stream, a); }
#endif
}
```

```cpp
#include <hip/hip_runtime.h>
#include <cstdio>
#include <cstdint>
namespace pg8 {
#define PG8_LAS __attribute__((address_space(3)))
typedef unsigned short bf16_t;
typedef short bf16x8 __attribute__((ext_vector_type(8)));
typedef float f32x4 __attribute__((ext_vector_type(4)));
typedef unsigned u32x4 __attribute__((ext_vector_type(4)));
constexpr int BM = 256, BK = 64, HALF = 128, HTB = HALF * BK * 2  , STAGE_BYTES = 8 * HTB, NXCD = 8, WGM = 8;

__host__ __device__ __forceinline__ int lds_byte(int r, int c) { const int st = (r >> 4) * 2 + (c >> 5), rr = r & 15, cc = c & 31, ob = rr * 64 + cc * 2; return st * 1024 + (ob ^ (((ob >> 9) & 1) << 5)); }
__host__ __device__ __forceinline__ void stage_rc(int b, int& R, int& C) { const int st = b / 1024, sb = b % 1024, swz = sb ^ (((sb >> 9) & 1) << 5); R = (st >> 1) * 16 + swz / 64; C = (st & 1) * 32 + (swz % 64) / 2; }
__host__ __device__ __forceinline__ int perm32(int rho) { const int n = rho >> 4, i = rho & 15; return 8 * (i >> 2) + 4 * n + (i & 3); }

struct Unit { int pm, pn, koff, ks; };
struct Gemm { const bf16_t* A; const bf16_t* Bt; int M, N, K, ld; };

struct StaticOrder {
    int nM, nN, nwg, G, c;
    __host__ __device__ void init(int M, int N, int G_, int c_) { nM = M / BM; nN = N / BM; nwg = nM * nN; G = G_; c = c_; }
    __host__ __device__ bool next(int i, Unit& u) const {
        const long L = (long)i * G + c; if (L >= nwg) return false;
        int wgid = (int)L; { const int q = nwg / NXCD, r = nwg % NXCD, xcd = wgid % NXCD, off = wgid / NXCD; wgid = (xcd < r ? xcd * (q + 1) : r * (q + 1) + (xcd - r) * q) + off; }
        const int nig = WGM * nN, gid = wgid / nig, fm = gid * WGM, gsz = (nM - fm) < WGM ? (nM - fm) : WGM;
        u.pm = fm + ((wgid % nig) % gsz); u.pn = (wgid % nig) / gsz; u.koff = 0; u.ks = 0; return true;
    }
    __device__ __forceinline__ void a_ready(const Unit&) const {}
    __device__ __forceinline__ void done(const Unit&) const {}
};

__device__ __forceinline__ unsigned cvt_pk_bf16(float lo, float hi) { unsigned r; asm volatile("v_cvt_pk_bf16_f32 %0, %1, %2" : "=v"(r) : "v"(lo), "v"(hi)); return r; }
typedef float f32x2 __attribute__((ext_vector_type(2)));
__device__ __forceinline__ f32x2 gelu_pk(f32x2 v) {
    const f32x2 av = __builtin_elementwise_abs(v), d = av * 0.2316418882f + 1.0f;
    f32x2 t; t.x = __builtin_amdgcn_rcpf(d.x); t.y = __builtin_amdgcn_rcpf(d.y);
    f32x2 q = t * 0.5307027145f + (-0.7265760135f); q = q * t + 0.7107068705f; q = q * t + (-0.142248368f); q = q * t + 0.127414796f; q = q * t;
    const f32x2 s = (v * v) * (-0.72134752044f);
    f32x2 e; e.x = __builtin_amdgcn_exp2f(s.x); e.y = __builtin_amdgcn_exp2f(s.y);
    const f32x2 m = v * (q * e), r = v - m;
    f32x2 o; o.x = v.x < 0.f ? m.x : r.x; o.y = v.y < 0.f ? m.y : r.y; return o;
}

template <int ACT  > struct EpiBf16 {
    static constexpr bool PERM = true, AFTER_DRAIN = false; static_assert(ACT == 0 || ACT == 1, "EpiBf16: ACT is 0 (none) or 1 (gelu_pk)");
    bf16_t* O; int ldc; const float* bias; int split_cols; size_t split_stride; float scale0;
    __device__ __forceinline__ void operator()(const f32x4 (&acc)[2][2][4][2], const Unit& u, int wr, int wc, int fr, int fq) const {
        const int row0 = u.pm * BM + wr * 64 + fr; int colt = u.pn * BM; bf16_t* base = O;
        float sc = 1.f; if (split_cols) { const int t = colt / split_cols; base += (size_t)t * split_stride; colt -= t * split_cols; if (t == 0) sc = scale0; }
        const int col0 = colt + wc * 32 + 8 * fq, bcol0 = u.pn * BM + wc * 32 + 8 * fq;
        f32x4 bv[2][2];
#pragma unroll
        for (int bj = 0; bj < 2; ++bj)
#pragma unroll
            for (int n = 0; n < 2; ++n) bv[bj][n] = bias ? *(const f32x4*)(bias + bcol0 + bj * HALF + 4 * n) : (f32x4){0.f, 0.f, 0.f, 0.f};
#pragma unroll
        for (int ai = 0; ai < 2; ++ai)
#pragma unroll
            for (int m = 0; m < 4; ++m) { bf16_t* rowp = base + (size_t)(row0 + ai * HALF + m * 16) * ldc + col0;
#pragma unroll
                for (int bj = 0; bj < 2; ++bj) { f32x4 v0 = acc[ai][bj][m][0] + bv[bj][0], v1 = acc[ai][bj][m][1] + bv[bj][1];
                    if (ACT == 1) { f32x2 a = gelu_pk((f32x2){v0[0], v0[1]}), b = gelu_pk((f32x2){v0[2], v0[3]}), c = gelu_pk((f32x2){v1[0], v1[1]}), d = gelu_pk((f32x2){v1[2], v1[3]});
                        v0 = (f32x4){a.x, a.y, b.x, b.y}; v1 = (f32x4){c.x, c.y, d.x, d.y}; }
                    v0 = v0 * sc; v1 = v1 * sc; u32x4 w; w.x = cvt_pk_bf16(v0[0], v0[1]); w.y = cvt_pk_bf16(v0[2], v0[3]); w.z = cvt_pk_bf16(v1[0], v1[1]); w.w = cvt_pk_bf16(v1[2], v1[3]);
                    *(u32x4*)(rowp + bj * HALF) = w; } }
    }
};

__device__ __forceinline__ float gelu_tanh_f(float x) {
    const float u = x * (1.0f + 0.044715f * x * x);
    const float e = __builtin_amdgcn_exp2f(-2.302208198f * u);
    return x * __builtin_amdgcn_rcpf(1.0f + e);
}
__device__ __forceinline__ float sigmoid_f(float x) { return __builtin_amdgcn_rcpf(1.0f + __builtin_amdgcn_exp2f(-1.442695041f * x)); }

struct EpiXG {
    static constexpr bool PERM = true, AFTER_DRAIN = false;
    bf16_t* O;
    __device__ __forceinline__ void operator()(const f32x4 (&acc)[2][2][4][2], const Unit& u, int wr, int wc, int fr, int fq) const {
        const int row0 = u.pm * BM + wr * 64 + fr, col0 = u.pn * BM + wc * 32 + 8 * fq;
#pragma unroll
        for (int ai = 0; ai < 2; ++ai)
#pragma unroll
            for (int m = 0; m < 4; ++m) { bf16_t* rowp = O + (size_t)(row0 + ai * HALF + m * 16) * 2816 + col0;
#pragma unroll
                for (int bj = 0; bj < 2; ++bj) { f32x4 v0 = acc[ai][bj][m][0], v1 = acc[ai][bj][m][1];
                    if (u.pn * BM + bj * HALF >= 1408) {
#pragma unroll
                        for (int j = 0; j < 4; ++j) { v0[j] = gelu_tanh_f(v0[j]); v1[j] = gelu_tanh_f(v1[j]); } }
                    u32x4 w; w.x = cvt_pk_bf16(v0[0], v0[1]); w.y = cvt_pk_bf16(v0[2], v0[3]); w.z = cvt_pk_bf16(v1[0], v1[1]); w.w = cvt_pk_bf16(v1[2], v1[3]);
                    *(u32x4*)(rowp + bj * HALF) = w; } }
    }
};
template <int ACT> struct EpiGated {
    static constexpr bool PERM = true, AFTER_DRAIN = false;
    bf16_t* O; int ldc;
    __device__ __forceinline__ void operator()(const f32x4 (&acc)[2][2][4][2], const Unit& u, int wr, int wc, int fr, int fq) const {
        const int row0 = u.pm * BM + wr * 64 + fr, col0 = u.pn * HALF + wc * 32 + 8 * fq;
#pragma unroll
        for (int ai = 0; ai < 2; ++ai)
#pragma unroll
            for (int m = 0; m < 4; ++m) { bf16_t* rowp = O + (size_t)(row0 + ai * HALF + m * 16) * ldc + col0;
                f32x4 o[2];
#pragma unroll
                for (int n = 0; n < 2; ++n)
#pragma unroll
                    for (int j = 0; j < 4; ++j) { const float a = acc[ai][0][m][n][j], b = acc[ai][1][m][n][j];
                        o[n][j] = (ACT == 0) ? (a * sigmoid_f(a)) * b : a * sigmoid_f(b); }
                u32x4 w; w.x = cvt_pk_bf16(o[0][0], o[0][1]); w.y = cvt_pk_bf16(o[0][2], o[0][3]); w.z = cvt_pk_bf16(o[1][0], o[1][1]); w.w = cvt_pk_bf16(o[1][2], o[1][3]);
                *(u32x4*)rowp = w; }
    }
};
struct EpiPlain {
    static constexpr bool PERM = true, AFTER_DRAIN = false;
    bf16_t* O; int ldc;
    __device__ __forceinline__ void operator()(const f32x4 (&acc)[2][2][4][2], const Unit& u, int wr, int wc, int fr, int fq) const {
        const int row0 = u.pm * BM + wr * 64 + fr, col0 = u.pn * BM + wc * 32 + 8 * fq;
#pragma unroll
        for (int ai = 0; ai < 2; ++ai)
#pragma unroll
            for (int m = 0; m < 4; ++m) { bf16_t* rowp = O + (size_t)(row0 + ai * HALF + m * 16) * ldc + col0;
#pragma unroll
                for (int bj = 0; bj < 2; ++bj) { const f32x4 v0 = acc[ai][bj][m][0], v1 = acc[ai][bj][m][1];
                    u32x4 w; w.x = cvt_pk_bf16(v0[0], v0[1]); w.y = cvt_pk_bf16(v0[2], v0[3]); w.z = cvt_pk_bf16(v1[0], v1[1]); w.w = cvt_pk_bf16(v1[2], v1[3]);
                    *(u32x4*)(rowp + bj * HALF) = w; } }
    }
};


struct SplitOrder {
    int nN, S, klen, G, c, pm;
    __device__ __forceinline__ bool next(int i, Unit& u) const { const int L = i * G + c; if (L >= nN * S) return false; u.pm = pm; u.pn = L % nN; u.ks = L / nN; u.koff = u.ks * klen; return true; }
    __device__ __forceinline__ void a_ready(const Unit&) const {}
    __device__ __forceinline__ void done(const Unit&) const {}
};
struct EpiSlab {
    static constexpr bool PERM = false, AFTER_DRAIN = false;
    float* S; int N;
    __device__ __forceinline__ void operator()(const f32x4 (&acc)[2][2][4][2], const Unit& u, int wr, int wc, int fr, int fq) const {
        const int row0 = wr * 64 + fr, col0 = u.pn * BM + wc * 32 + 4 * fq; float* base = S + (size_t)u.ks * 144 * N;
#pragma unroll
        for (int ai = 0; ai < 2; ++ai)
#pragma unroll
            for (int m = 0; m < 4; ++m) { const int r = row0 + ai * HALF + m * 16;
                if (r < 144) { float* rowp = base + (size_t)r * N + col0;
#pragma unroll
                    for (int bj = 0; bj < 2; ++bj)
#pragma unroll
                        for (int n = 0; n < 2; ++n) *(f32x4*)(rowp + bj * HALF + n * 16) = acc[ai][bj][m][n]; } }
    }
};
template <class Epi, class Sched, bool ALIGN_EPI = false, bool SP2 = false>
__device__ __forceinline__ void gemm_phase(PG8_LAS unsigned char* lds, const Gemm g, const Sched& S, const Epi& E) {
    const int tid = threadIdx.x, wid = __builtin_amdgcn_readfirstlane(tid >> 6), lane = tid & 63, wr = wid >> 2, wc = wid & 3, fr = lane & 15, fq = lane >> 4;
    const int K = g.K, nt = K / BK, ld = g.ld;
    unsigned voffA[2], voffB[2];
#pragma unroll
    for (int i = 0; i < 2; ++i) { int R, C; stage_rc(tid * 16 + i * 8192, R, C); const int Rb = Epi::PERM ? ((R & ~31) + perm32(R & 31)) : R;
        voffA[i] = (unsigned)(R * ld + C) * 2u; voffB[i] = (unsigned)(Rb * ld + C) * 2u; }
    const size_t kstep = (size_t)(BK * 2);
    const size_t hstep = (size_t)HALF * ld * 2;
    const size_t tstep = 2 * hstep;
    const unsigned ldsw = (unsigned)wid * 1024u;
    const int aoff = lds_byte(wr * 64 + fr, fq * 8), boff = lds_byte(wc * 32 + fr, fq * 8);
#define PG8_SA(b, h) (((b) * 2 + (h)) * HTB)
#define PG8_SB(b, h) ((4 + (b) * 2 + (h)) * HTB)
#define PG8_STAGE(bufoff, gbase, voff) do { _Pragma("unroll") for (int _i = 0; _i < 2; ++_i) \
        __builtin_amdgcn_global_load_lds((const unsigned*)((const char*)(gbase) + (voff)[_i]), (PG8_LAS unsigned*)(lds + (bufoff) + ldsw + _i * 8192), 16, 0, 0); } while (0)
#define PG8_LDA(dst, b, h) do { _Pragma("unroll") for (int m = 0; m < 4; ++m) _Pragma("unroll") for (int k = 0; k < 2; ++k) dst[m][k] = *(const PG8_LAS bf16x8*)(lds + PG8_SA(b, h) + aoff + m * 2048 + k * 1024); } while (0)
#define PG8_LDB(dst, b, h) do { _Pragma("unroll") for (int n = 0; n < 2; ++n) _Pragma("unroll") for (int k = 0; k < 2; ++k) dst[n][k] = *(const PG8_LAS bf16x8*)(lds + PG8_SB(b, h) + boff + n * 2048 + k * 1024); } while (0)
#define PG8_MMA(ai, bj, At, Bt) do { __builtin_amdgcn_s_setprio(1); _Pragma("unroll") for (int m = 0; m < 4; ++m) _Pragma("unroll") for (int n = 0; n < 2; ++n) _Pragma("unroll") for (int k = 0; k < 2; ++k) \
        acc[ai][bj][m][n] = __builtin_amdgcn_mfma_f32_16x16x32_bf16(Bt[n][k], At[m][k], acc[ai][bj][m][n], 0, 0, 0); __builtin_amdgcn_s_setprio(0); } while (0)
#define PG8_WAIT_V(n) asm volatile("s_waitcnt vmcnt(" #n ")" ::: "memory")
#define PG8_WAIT_L(n) asm volatile("s_waitcnt lgkmcnt(" #n ")" ::: "memory")
#define PG8_BAR __builtin_amdgcn_s_barrier()
#define PG8_SCHED __builtin_amdgcn_sched_barrier(0)
    Unit cur, nxt; int ui = 0;
    if (!S.next(0, cur)) return;
    f32x4 acc[2][2][4][2];
#pragma unroll
    for (int a = 0; a < 2; ++a)
#pragma unroll
        for (int b = 0; b < 2; ++b)
#pragma unroll
            for (int m = 0; m < 4; ++m)
#pragma unroll
                for (int n = 0; n < 2; ++n) acc[a][b][m][n] = (f32x4){0.f, 0.f, 0.f, 0.f};
    bf16x8 At[4][2], B0[2][2], B1[2][2];
    const char* cA = (const char*)g.A + (size_t)cur.pm * tstep + (size_t)cur.koff * 2; const char* cB = (const char*)g.Bt + (size_t)cur.pn * tstep + (size_t)cur.koff * 2;
    S.a_ready(cur);
    if constexpr (SP2) {
        PG8_STAGE(PG8_SB(0, 0), cB, voffB); PG8_STAGE(PG8_SB(0, 1), cB + hstep, voffB); PG8_STAGE(PG8_SA(0, 0), cA, voffA); PG8_STAGE(PG8_SA(0, 1), cA + hstep, voffA);
        if (wr == 1) PG8_BAR;
        PG8_WAIT_V(2); PG8_BAR;
        PG8_STAGE(PG8_SB(1, 0), cB + kstep, voffB); PG8_STAGE(PG8_SA(1, 0), cA + kstep, voffA); PG8_STAGE(PG8_SB(1, 1), cB + hstep + kstep, voffB);
        PG8_WAIT_V(6); PG8_BAR;
    } else {
        PG8_STAGE(PG8_SB(0, 0), cB, voffB); PG8_STAGE(PG8_SA(0, 0), cA, voffA); PG8_STAGE(PG8_SB(0, 1), cB + hstep, voffB); PG8_STAGE(PG8_SA(0, 1), cA + hstep, voffA);
        if (wr == 1) PG8_BAR;
        PG8_WAIT_V(4); PG8_BAR;
        PG8_STAGE(PG8_SB(1, 0), cB + kstep, voffB); PG8_STAGE(PG8_SA(1, 0), cA + kstep, voffA); PG8_STAGE(PG8_SB(1, 1), cB + hstep + kstep, voffB);
        PG8_WAIT_V(6); PG8_BAR;
    }
    for (;;) {
        const bool has_next = S.next(ui + 1, nxt);
        const char* nA = has_next ? (const char*)g.A + (size_t)nxt.pm * tstep + (size_t)nxt.koff * 2 : cA; const char* nB = has_next ? (const char*)g.Bt + (size_t)nxt.pn * tstep + (size_t)nxt.koff * 2 : cB;
        for (int t = 0; t < nt; t += 2) {
            const bool last = (t == nt - 2);
            const char* a1 = cA + (size_t)(t + 1) * kstep;
            const char* a2 = last ? nA : cA + (size_t)(t + 2) * kstep; const char* b2 = last ? nB : cB + (size_t)(t + 2) * kstep;
            const char* a3 = a2 + kstep; const char* b3 = b2 + kstep;
            if (last && has_next) S.a_ready(nxt);
            if constexpr (SP2) {
            PG8_LDB(B0, 0, 0); PG8_LDB(B1, 0, 1); PG8_SCHED; PG8_LDA(At, 0, 0); PG8_STAGE(PG8_SA(1, 1), a1 + hstep, voffA);
            PG8_WAIT_V(8); PG8_WAIT_L(0); PG8_BAR; PG8_MMA(0, 0, At, B0); PG8_MMA(0, 1, At, B1); PG8_BAR; PG8_SCHED;
            PG8_LDA(At, 0, 1); PG8_STAGE(PG8_SB(0, 0), b2, voffB); PG8_STAGE(PG8_SB(0, 1), b2 + hstep, voffB); PG8_STAGE(PG8_SA(0, 0), a2, voffA);
            PG8_WAIT_V(8); PG8_WAIT_L(0); PG8_BAR; PG8_MMA(1, 0, At, B0); PG8_MMA(1, 1, At, B1); PG8_BAR; PG8_SCHED;
            PG8_LDB(B0, 1, 0); PG8_LDB(B1, 1, 1); PG8_SCHED; PG8_LDA(At, 1, 0); PG8_STAGE(PG8_SA(0, 1), a2 + hstep, voffA);
            PG8_WAIT_V(8); PG8_WAIT_L(0); PG8_BAR; PG8_MMA(0, 0, At, B0); PG8_MMA(0, 1, At, B1); PG8_BAR; PG8_SCHED;
            PG8_LDA(At, 1, 1); PG8_STAGE(PG8_SB(1, 0), b3, voffB); PG8_STAGE(PG8_SB(1, 1), b3 + hstep, voffB); PG8_STAGE(PG8_SA(1, 0), a3, voffA);
            PG8_WAIT_V(8); PG8_WAIT_L(0); PG8_BAR; PG8_MMA(1, 0, At, B0); PG8_MMA(1, 1, At, B1); PG8_BAR; PG8_SCHED;
            } else {
            PG8_LDB(B0, 0, 0); PG8_SCHED; PG8_LDA(At, 0, 0); PG8_STAGE(PG8_SA(1, 1), a1 + hstep, voffA);
            PG8_WAIT_L(8); PG8_BAR; PG8_WAIT_L(0); PG8_MMA(0, 0, At, B0); PG8_BAR; PG8_SCHED;
            PG8_LDB(B1, 0, 1); PG8_STAGE(PG8_SB(0, 0), b2, voffB);
            PG8_BAR; PG8_WAIT_L(0); PG8_MMA(0, 1, At, B1); PG8_BAR;
            PG8_LDA(At, 0, 1); PG8_STAGE(PG8_SA(0, 0), a2, voffA);
            PG8_BAR; PG8_WAIT_L(0); PG8_MMA(1, 0, At, B0); PG8_BAR; PG8_SCHED;
            PG8_STAGE(PG8_SB(0, 1), b2 + hstep, voffB);
            PG8_WAIT_V(6); PG8_BAR; PG8_MMA(1, 1, At, B1); PG8_BAR;
            PG8_LDB(B0, 1, 0); PG8_SCHED; PG8_LDA(At, 1, 0); PG8_STAGE(PG8_SA(0, 1), a2 + hstep, voffA);
            PG8_WAIT_L(8); PG8_BAR; PG8_WAIT_L(0); PG8_MMA(0, 0, At, B0); PG8_BAR; PG8_SCHED;
            PG8_LDB(B1, 1, 1); PG8_STAGE(PG8_SB(1, 0), b3, voffB);
            PG8_BAR; PG8_WAIT_L(0); PG8_MMA(0, 1, At, B1); PG8_BAR;
            PG8_LDA(At, 1, 1); PG8_STAGE(PG8_SA(1, 0), a3, voffA);
            PG8_BAR; PG8_WAIT_L(0); PG8_MMA(1, 0, At, B0); PG8_BAR; PG8_SCHED;
            PG8_STAGE(PG8_SB(1, 1), b3 + hstep, voffB);
            PG8_WAIT_V(6); PG8_BAR; PG8_MMA(1, 1, At, B1); PG8_BAR;
            }
        }
        if constexpr (ALIGN_EPI) { if (wr == 0) PG8_BAR; }
        if constexpr (!Epi::AFTER_DRAIN) { E(acc, cur, wr, wc, fr, fq); S.done(cur); }
        if (!has_next) break;
#pragma unroll
        for (int a = 0; a < 2; ++a)
#pragma unroll
            for (int b = 0; b < 2; ++b)
#pragma unroll
                for (int m = 0; m < 4; ++m)
#pragma unroll
                    for (int n = 0; n < 2; ++n) acc[a][b][m][n] = (f32x4){0.f, 0.f, 0.f, 0.f};
        cur = nxt; cA = nA; cB = nB; ++ui;
        if constexpr (ALIGN_EPI) { if (wr == 1) PG8_BAR; }
    }
    PG8_WAIT_V(0);
    if constexpr (!ALIGN_EPI) { if (wr == 0) PG8_BAR; }
    PG8_BAR;
    if constexpr (Epi::AFTER_DRAIN) { E.fused(acc, cur, wr, wc, fr, fq, lds, wid, lane); S.done(cur); }
#undef PG8_SA
#undef PG8_SB
#undef PG8_STAGE
#undef PG8_LDA
#undef PG8_LDB
#undef PG8_MMA
#undef PG8_WAIT_V
#undef PG8_WAIT_L
#undef PG8_BAR
#undef PG8_SCHED
}
}

#ifndef PG8_SP2
#define PG8_SP2 true
#endif
#ifndef PG8_ALIGN
#define PG8_ALIGN true
#endif

constexpr int NWAVES = 8;
constexpr int D = 1024, DR = 1408, DFF = 2816, NBATCH = 8, SEQ = 2048, NMETA = 16, NSMP = 128;
constexpr int LRU_BW = 88;
constexpr int MROWS = 16640;
constexpr int R_META = 16384, R_SMP = 16400, R_END = 16528;
constexpr int S5_RB = 1160;
constexpr float RMS_EPS = 1e-6f;
constexpr size_t O_YP = 0, O_YS = 16777216, O_LHP = 16908288, O_LCP = 16919552, O_SRP = 16953344, O_SIP = 16986112,
                 O_LHS = 17018880, O_LCS = 17199104, O_SRS = 17739776, O_SIS = 18264064, O_END = 18788352;
constexpr size_t al256(size_t x) { return (x + 255) & ~(size_t)255; }
constexpr size_t WS_CTL = 0, CTL_ZERO_BYTES = 1u << 20;
constexpr size_t WS_W1T = CTL_ZERO_BYTES;
constexpr size_t WS_W2T = WS_W1T + (size_t)2816 * 1024 * 2;
constexpr size_t WS_W3T = WS_W2T + (size_t)1024 * 1408 * 2;
constexpr size_t WS_W4T = WS_W3T + (size_t)2 * 5632 * 1024 * 2;
constexpr size_t WS_W5T = WS_W4T + (size_t)2 * 1024 * 2816 * 2;
constexpr size_t WS_WGT = WS_W5T + (size_t)2048 * 1024 * 2;
constexpr size_t WS_S5WE = WS_WGT + (size_t)16 * 2 * 96 * 96 * 2;
constexpr size_t WS_S5WY = WS_S5WE + (size_t)64 * 128 * 256 * 2;
constexpr size_t WS_S5C = WS_S5WY + (size_t)64 * 256 * 384 * 2;
constexpr size_t WS_XEX = WS_S5C + (size_t)6 * 4096 * 4;
constexpr size_t WS_XN = WS_XEX + (size_t)256 * 1024 * 4;
constexpr size_t WS_R1 = WS_XN + (size_t)MROWS * 1024 * 2;
constexpr size_t WS_R2 = WS_R1 + (size_t)MROWS * 2816 * 2;
constexpr size_t WS_SLAB = WS_R2 + (size_t)MROWS * 1408 * 2;
constexpr size_t WS_END = WS_SLAB + (size_t)11 * 144 * 1024 * 4;
static_assert(WS_END <= (size_t)268435456, "d_ws map exceeds 256 MiB");
static_assert((WS_W1T % 256) == 0 && (WS_W2T % 256) == 0 && (WS_W3T % 256) == 0 && (WS_W4T % 256) == 0 && (WS_W5T % 256) == 0 && (WS_WGT % 256) == 0 && (WS_S5WE % 256) == 0 &&
              (WS_S5WY % 256) == 0 && (WS_S5C % 256) == 0 && (WS_XEX % 256) == 0 && (WS_XN % 256) == 0 && (WS_R1 % 256) == 0 && (WS_R2 % 256) == 0, "alignment");
constexpr int CW_BAR = 4096;
constexpr int RING_OFF = 0, RING_BYTES = 131072;
constexpr int LDSCTL_OFF = RING_BYTES, MISC_OFF = LDSCTL_OFF + 320;
constexpr int LDS_BYTES = 147456;

#define GAS __attribute__((address_space(1)))
#define LAS __attribute__((address_space(3)))
typedef unsigned short bf16;
typedef unsigned v4u __attribute__((ext_vector_type(4)));
typedef unsigned v2u __attribute__((ext_vector_type(2)));
typedef float f32x4 __attribute__((ext_vector_type(4)));
typedef short bf16x8 __attribute__((ext_vector_type(8)));
typedef GAS unsigned gu32;
#define LDS_WAIT() asm volatile("s_waitcnt lgkmcnt(0)" ::: "memory")
#define VM_WAIT() asm volatile("s_waitcnt vmcnt(0)" ::: "memory")
__device__ __forceinline__ unsigned f2bf(float f) { unsigned u = __builtin_bit_cast(unsigned, f); return (u + 0x7fffu + ((u >> 16) & 1u)) >> 16; }
__device__ __forceinline__ unsigned pk2(float lo, float hi) { return f2bf(lo) | (f2bf(hi) << 16); }
__device__ __forceinline__ float bf2f(unsigned short b) { return __builtin_bit_cast(float, (unsigned)b << 16); }
__device__ __forceinline__ float bflo(unsigned w) { return __builtin_bit_cast(float, w << 16); }
__device__ __forceinline__ float bfhi(unsigned w) { return __builtin_bit_cast(float, w & 0xffff0000u); }
__device__ __forceinline__ float wave_sum(float v) {
#pragma unroll
    for (int o = 1; o < 64; o <<= 1) v += __shfl_xor(v, o);
    return v;
}
using pg8::gelu_tanh_f; using pg8::sigmoid_f;

#define XB_TMO      128
#define XB_XCNT(j)  (256  + 64 * (j))
#define XB_XSUB(j)  (1280 + 64 * (j))
#define XB_XGEN(j)  (2304 + 64 * (j))
#define XB_TOP      3328
#define XB_TOPGEN   3392
#define XCD_BAR_WORDS 3456
#define XB_SPIN_CAP (1u << 18)

__device__ __forceinline__ unsigned xb_ld(unsigned* p)              { return __hip_atomic_load(p, __ATOMIC_RELAXED, __HIP_MEMORY_SCOPE_AGENT); }
__device__ __forceinline__ unsigned xb_add(unsigned* p, unsigned v) { return __hip_atomic_fetch_add(p, v, __ATOMIC_RELAXED, __HIP_MEMORY_SCOPE_AGENT); }
__device__ __forceinline__ unsigned xb_xcc_id() { return (unsigned)__builtin_amdgcn_s_getreg((3 << 11) | 20) & 0xFu; }
#define XB_SPIN(cond, bar) do { unsigned _sp = 0; while (cond) { __builtin_amdgcn_s_sleep(1); \
    if ((++_sp & 255u) == 0u) { if (xb_ld(&(bar)[XB_TMO])) break; if (_sp > XB_SPIN_CAP) { atomicAdd(&(bar)[XB_TMO], 1u); break; } } } } while (0)

struct XcdBarrier {
    unsigned* bar; unsigned x;
    volatile LAS unsigned* st;
};

__device__ __forceinline__ XcdBarrier xcd_barrier_post(unsigned* bar, volatile LAS unsigned* st) {
    XcdBarrier b; b.bar = bar; b.x = xb_xcc_id(); b.st = st;
    if (threadIdx.x == 0) (void)xb_add(&bar[XB_XCNT(b.x)], 1u);
    return b;
}
__device__ __forceinline__ void xcd_barrier_complete(unsigned* bar, unsigned x, unsigned& nloc, unsigned& nx) {
    const unsigned G = gridDim.x * gridDim.y * gridDim.z;
    unsigned sum, cnt, mine, sp = 0u;
    for (;;) {
        sum = 0u; cnt = 0u; mine = 0u;
#pragma unroll
        for (unsigned j = 0; j < 16; ++j) { const unsigned c = xb_ld(&bar[XB_XCNT(j)]); sum += c; cnt += (c > 0u) ? 1u : 0u; mine = (j == x) ? c : mine; }
        if (sum == G) break;
        __builtin_amdgcn_s_sleep(1);
        if ((++sp & 255u) == 0u) { if (xb_ld(&bar[XB_TMO])) break; if (sp > XB_SPIN_CAP) { atomicAdd(&bar[XB_TMO], 1u); break; } }
    }
    nloc = mine > 0u ? mine : 1u; nx = cnt > 0u ? cnt : 1u;
}

__device__ __forceinline__ void xcd_barrier(const XcdBarrier& b) {
    asm volatile("s_waitcnt vmcnt(0)" ::: "memory");
    __syncthreads();
    if (threadIdx.x == 0) {
        unsigned* bar = b.bar;
        __builtin_amdgcn_s_waitcnt(0);
        unsigned nloc = b.st[0], nx = b.st[1];
        if (nloc == 0u) { xcd_barrier_complete(bar, b.x, nloc, nx); b.st[0] = nloc; b.st[1] = nx; }
        const unsigned old = xb_add(&bar[XB_XSUB(b.x)], 1u);
        const unsigned gen = old / nloc;
        if (old + 1u == (gen + 1u) * nloc) {
            __builtin_amdgcn_fence(__ATOMIC_RELEASE, "agent");
            asm volatile("s_waitcnt vmcnt(0)" ::: "memory");
            const unsigned og = xb_add(&bar[XB_TOP], 1u);
            const unsigned tg = og / nx;
            if (og + 1u == (tg + 1u) * nx) xb_add(&bar[XB_TOPGEN], 1u);
            else XB_SPIN(xb_ld(&bar[XB_TOPGEN]) == tg, bar);
            __builtin_amdgcn_fence(__ATOMIC_ACQUIRE, "agent");
            xb_add(&bar[XB_XGEN(b.x)], 1u);
            asm volatile("s_waitcnt vmcnt(0)" ::: "memory");
        } else {
            XB_SPIN(xb_ld(&bar[XB_XGEN(b.x)]) == gen, bar);
            __builtin_amdgcn_fence(__ATOMIC_ACQUIRE, "agent");
            asm volatile("s_waitcnt vmcnt(0)" ::: "memory");
        }
    }
    __syncthreads();
}

struct Args { const float* in[28]; float* out; unsigned char* ws; int ph_lo, ph_hi; };
enum { I_XP = 0, I_XS, I_LH, I_LC, I_SRE, I_SIM, I_META, I_GAIN, I_LWIN, I_LWCONV, I_LBCONV, I_LWA, I_LBA, I_LWX, I_LBX, I_LLAM, I_LWOUT,
       I_SLRE, I_SLIM, I_SLDT, I_SBRE, I_SBIM, I_SCRE, I_SCIM, I_SD, I_SWOUT, I_FWIN, I_FWOUT };

struct Ctx {
    LAS unsigned char* lds;
    int tid, lane, wave, vcu, G;
    const float* const* in; float* out; unsigned char* ws;
};

__device__ __forceinline__ void transpose_item(const float* W, int K, int N, bf16* WT, int half, LAS float* scr, int item, int lane) {
    const int nblk = N / 32, kb = item / nblk, nb = item % nblk, k0 = 64 * kb, n0 = 32 * nb;
    int r0 = n0;
    if (half) { const int c = n0 < half ? n0 : n0 - half; r0 = 256 * (c >> 7) + (c & 127) + (n0 < half ? 0 : 128); }
#pragma unroll 8
    for (int i = 0; i < 32; ++i) { const int kk = 2 * i + (lane >> 5); scr[kk * 33 + (lane & 31)] = W[(size_t)(k0 + kk) * N + n0 + (lane & 31)]; }
    LDS_WAIT(); asm volatile("" ::: "memory");
    const int c = lane & 7;
#pragma unroll
    for (int j = 0; j < 4; ++j) { const int n = (lane >> 3) + 8 * j; const LAS float* s = scr + (8 * c) * 33 + n;
        v4u o; o.x = pk2(s[0 * 33], s[1 * 33]); o.y = pk2(s[2 * 33], s[3 * 33]); o.z = pk2(s[4 * 33], s[5 * 33]); o.w = pk2(s[6 * 33], s[7 * 33]);
        *(GAS v4u*)(WT + (size_t)(r0 + n) * K + k0 + 8 * c) = o; }
    LDS_WAIT(); asm volatile("" ::: "memory");
}
__device__ __forceinline__ const float* x0_row(const Ctx& C, int r) {
    if (r < R_META) return C.in[I_XP] + (size_t)r * D;
    if (r < R_SMP) return C.in[I_META] + (size_t)(r - R_META) * D;
    return C.in[I_XS] + (size_t)(r - R_SMP) * D;
}
__device__ __forceinline__ float* xs_row(const Ctx& C, int r) {
    if (r < R_META) return C.out + O_YP + (size_t)r * D;
    return (float*)(C.ws + WS_XEX) + (size_t)(r - R_META) * D;
}
__device__ __forceinline__ float sin2pi(float turns) { return __builtin_amdgcn_sinf(turns - rintf(turns)); }
__device__ __forceinline__ float cos2pi(float turns) { return __builtin_amdgcn_cosf(turns - rintf(turns)); }

__device__ __forceinline__ void s5_prep_group(const Ctx& C, int g) {
    LAS float* PWr = (LAS float*)(C.lds + RING_OFF);
    LAS float* PWi = PWr + 17 * 64;
    LAS float* BBr = PWi + 17 * 64;
    LAS float* BBi = BBr + 1024;
    LAS float* Cr = BBi + 1024;
    LAS float* Ci = Cr + 1024;
    LAS float* KT = Ci + 1024;
    const int tid = C.tid;
    const float INV2PI = 0.15915494309189535f;
    if (tid < 64) {
        const int p = tid;
        const float dt = expf(C.in[I_SLDT][g]);
        const float lr = C.in[I_SLRE][g * 64 + p], li = C.in[I_SLIM][g * 64 + p];
        const float x = dt * lr, y = dt * li, yt = y * INV2PI;
        for (int tau = 0; tau <= 16; ++tau) { const float mag = expf((float)tau * x), tr = (float)tau * yt;
            PWr[tau * 64 + p] = mag * cos2pi(tr); PWi[tau * 64 + p] = mag * sin2pi(tr); }
        const float em1 = expm1f(x), cy = cos2pi(yt), sy = sin2pi(yt), sh = sin2pi(0.5f * yt), cm1 = -2.0f * sh * sh;
        const float ar = em1 * cy + cm1, ai = (em1 + 1.0f) * sy;
        const float den = 1.0f / (lr * lr + li * li);
        const float qr = (ar * lr + ai * li) * den, qi = (ai * lr - ar * li) * den;
        for (int c = 0; c < 16; ++c) { const float br = C.in[I_SBRE][(size_t)(g * 64 + p) * 16 + c], bi = C.in[I_SBIM][(size_t)(g * 64 + p) * 16 + c];
            BBr[p * 16 + c] = qr * br - qi * bi; BBi[p * 16 + c] = qr * bi + qi * br; }
        float* S5C = (float*)(C.ws + WS_S5C);
        S5C[0 * 4096 + g * 64 + p] = PWr[16 * 64 + p]; S5C[1 * 4096 + g * 64 + p] = PWi[16 * 64 + p];
        S5C[2 * 4096 + g * 64 + p] = PWr[1 * 64 + p];  S5C[3 * 4096 + g * 64 + p] = PWi[1 * 64 + p];
        const float mag = expf(-15.0f * x), tr = -15.0f * yt;
        S5C[4 * 4096 + g * 64 + p] = mag * cos2pi(tr); S5C[5 * 4096 + g * 64 + p] = mag * sin2pi(tr);
    }
    for (int i = tid; i < 1024; i += 512) { Cr[i] = C.in[I_SCRE][(size_t)g * 1024 + i]; Ci[i] = C.in[I_SCIM][(size_t)g * 1024 + i]; }
    __syncthreads();
    for (int e = tid; e < 4096; e += 512) { const int tau = e >> 8, co = (e >> 4) & 15, ci = e & 15; float acc = 0.f;
        for (int p = 0; p < 64; ++p) { const float pr = PWr[tau * 64 + p], pi = PWi[tau * 64 + p], br = BBr[p * 16 + ci], bi = BBi[p * 16 + ci];
            const float tr = pr * br - pi * bi, ti = pr * bi + pi * br; acc += Cr[co * 64 + p] * tr - Ci[co * 64 + p] * ti; }
        KT[e] = acc; }
    __syncthreads();
    bf16* WY = (bf16*)(C.ws + WS_S5WY) + (size_t)g * 256 * 384;
    for (int e = tid; e < 256 * 48; e += 512) { const int n = e / 48, kg = e % 48, t = n >> 4, co = n & 15; float v[8];
#pragma unroll
        for (int q = 0; q < 8; ++q) { const int k = kg * 8 + q; float val;
            if (k < 256) { const int s = k >> 4, ci = k & 15; val = (s <= t) ? KT[(t - s) * 256 + co * 16 + ci] : 0.f; }
            else if (k < 320) { const int p = k - 256; val = Cr[co * 64 + p] * PWr[(t + 1) * 64 + p] - Ci[co * 64 + p] * PWi[(t + 1) * 64 + p]; }
            else { const int p = k - 320; val = -(Cr[co * 64 + p] * PWi[(t + 1) * 64 + p] + Ci[co * 64 + p] * PWr[(t + 1) * 64 + p]); }
            v[q] = val; }
        v4u o; o.x = pk2(v[0], v[1]); o.y = pk2(v[2], v[3]); o.z = pk2(v[4], v[5]); o.w = pk2(v[6], v[7]);
        *(GAS v4u*)(WY + (size_t)n * 384 + kg * 8) = o; }
    bf16* WE = (bf16*)(C.ws + WS_S5WE) + (size_t)g * 128 * 256;
    for (int e = tid; e < 128 * 32; e += 512) { const int n = e >> 5, kg = e & 31, p = n & 63, im = n >> 6; float v[8];
#pragma unroll
        for (int q = 0; q < 8; ++q) { const int k = kg * 8 + q, s = k >> 4, ci = k & 15;
            const float pr = PWr[(15 - s) * 64 + p], pi = PWi[(15 - s) * 64 + p], br = BBr[p * 16 + ci], bi = BBi[p * 16 + ci];
            v[q] = im ? (pr * bi + pi * br) : (pr * br - pi * bi); }
        v4u o; o.x = pk2(v[0], v[1]); o.y = pk2(v[2], v[3]); o.z = pk2(v[4], v[5]); o.w = pk2(v[6], v[7]);
        *(GAS v4u*)(WE + (size_t)n * 256 + kg * 8) = o; }
    __syncthreads();
}

__device__ __forceinline__ void p0_prologue(const Ctx& C) {
    __syncthreads();
    if (C.vcu < 64) s5_prep_group(C, C.vcu);
    LAS float* scr = (LAS float*)(C.lds + RING_OFF + C.wave * 16384);
    const int gw = C.vcu * NWAVES + C.wave, NGW = C.G * NWAVES;
    constexpr int I_1 = (1024 / 64) * (2816 / 32), I_2 = (1408 / 64) * (1024 / 32), I_3 = (1024 / 64) * (5632 / 32), I_4 = (2816 / 64) * (1024 / 32), I_5 = (1024 / 64) * (2048 / 32);
    constexpr int NITEMS = I_1 + I_2 + 2 * I_3 + 2 * I_4 + I_5;
    for (int it = gw; it < NITEMS; it += NGW) {
        int r = it;
        if (r < I_1) { transpose_item(C.in[I_LWIN], 1024, 2816, (bf16*)(C.ws + WS_W1T), 0, scr, r, C.lane); continue; } r -= I_1;
        if (r < I_2) { transpose_item(C.in[I_LWOUT], 1408, 1024, (bf16*)(C.ws + WS_W2T), 0, scr, r, C.lane); continue; } r -= I_2;
        if (r < I_3) { transpose_item(C.in[I_FWIN], 1024, 5632, (bf16*)(C.ws + WS_W3T), 2816, scr, r, C.lane); continue; } r -= I_3;
        if (r < I_3) { transpose_item(C.in[I_FWIN] + (size_t)1024 * 5632, 1024, 5632, (bf16*)(C.ws + WS_W3T) + (size_t)5632 * 1024, 2816, scr, r, C.lane); continue; } r -= I_3;
        if (r < I_4) { transpose_item(C.in[I_FWOUT], 2816, 1024, (bf16*)(C.ws + WS_W4T), 0, scr, r, C.lane); continue; } r -= I_4;
        if (r < I_4) { transpose_item(C.in[I_FWOUT] + (size_t)2816 * 1024, 2816, 1024, (bf16*)(C.ws + WS_W4T) + (size_t)1024 * 2816, 0, scr, r, C.lane); continue; } r -= I_4;
        transpose_item(C.in[I_SWOUT], 1024, 2048, (bf16*)(C.ws + WS_W5T), 1024, scr, r, C.lane);
    }
    { bf16* WG = (bf16*)(C.ws + WS_WGT); const int gt = (C.vcu * NWAVES + C.wave) * 64 + C.lane, NT = C.G * 512;
      for (int e = gt; e < 16 * 2 * 96 * 96; e += NT) { const int i = e % 96, j = (e / 96) % 96, gate = (e / 9216) & 1, h = e / 18432;
          const float* wsel = gate ? C.in[I_LWX] : C.in[I_LWA]; float v = 0.f; if (i < 88 && j < 88) v = wsel[(size_t)(h * 88 + i) * 88 + j];
          WG[e] = (bf16)f2bf(v); } }
    { const float* gain = C.in[I_GAIN]; bf16* XN = (bf16*)(C.ws + WS_XN);
      for (int r = gw; r < R_END; r += NGW) {
          const GAS f32x4* xr = (const GAS f32x4*)x0_row(C, r) + C.lane; f32x4 v[4]; float s = 0.f;
#pragma unroll
          for (int j = 0; j < 4; ++j) { v[j] = xr[64 * j]; s += (v[j].x * v[j].x + v[j].y * v[j].y) + (v[j].z * v[j].z + v[j].w * v[j].w); }
          const float rs = rsqrtf(wave_sum(s) * (1.f / D) + RMS_EPS);
          GAS v2u* o8 = (GAS v2u*)(XN + (size_t)r * D) + C.lane;
#pragma unroll
          for (int j = 0; j < 4; ++j) { const f32x4 gg = *((const GAS f32x4*)gain + C.lane + 64 * j);
              v2u o; o.x = pk2(v[j].x * rs * gg.x, v[j].y * rs * gg.y); o.y = pk2(v[j].z * rs * gg.z, v[j].w * rs * gg.w); o8[64 * j] = o; } } }
}

template <int MODE>
__device__ __forceinline__ void nr_phase(const Ctx& C, const bf16* MB, const float* ga, const float* gb, int nslab, int ldn, bool glu) {
    const float* slab = (const float*)(C.ws + WS_SLAB);
    const int gw = C.vcu * NWAVES + C.wave, NGW = C.G * NWAVES, lane = C.lane;
    bf16* XN = (bf16*)(C.ws + WS_XN); bf16* XNS = (bf16*)(C.ws + WS_R1);
    for (int r = gw; r < R_END; r += NGW) {
        if (MODE == 3 && r >= R_META && r < R_SMP) continue;
        const float* xsrc = (MODE == 0) ? x0_row(C, r) : xs_row(C, r);
        float* xdst = (MODE == 3 && r >= R_SMP) ? C.out + O_YS + (size_t)(r - R_SMP) * D : xs_row(C, r);
        const GAS v2u* mr = (const GAS v2u*)(MB + (size_t)r * D) + lane;
        f32x4 m[4], x[4]; float s = 0.f;
#pragma unroll
        for (int j = 0; j < 4; ++j) {
            if (r < R_META) { const v2u w = mr[64 * j]; m[j] = (f32x4){bflo(w.x), bfhi(w.x), bflo(w.y), bfhi(w.y)}; }
            else {
                const int er = r - R_META; f32x4 a0 = {0.f, 0.f, 0.f, 0.f}, a1 = {0.f, 0.f, 0.f, 0.f};
                const int cz = glu ? 256 * (2 * j + (lane >> 5)) + 4 * (lane & 31) : 256 * j + 4 * lane;
                for (int sidx = 0; sidx < nslab; ++sidx) { const float* sp = slab + ((size_t)sidx * 144 + er) * ldn + cz;
                    a0 = a0 + *(const GAS f32x4*)sp; if (glu) a1 = a1 + *(const GAS f32x4*)(sp + 128); }
                if (glu) { a0.x *= sigmoid_f(a1.x); a0.y *= sigmoid_f(a1.y); a0.z *= sigmoid_f(a1.z); a0.w *= sigmoid_f(a1.w); }
                m[j] = a0; }
            x[j] = *((const GAS f32x4*)xsrc + lane + 64 * j);
            s += (m[j].x * m[j].x + m[j].y * m[j].y) + (m[j].z * m[j].z + m[j].w * m[j].w); }
        const float rs = rsqrtf(wave_sum(s) * (1.f / D) + RMS_EPS);
        float s2 = 0.f;
#pragma unroll
        for (int j = 0; j < 4; ++j) { const f32x4 gg = *((const GAS f32x4*)ga + lane + 64 * j);
            x[j] = x[j] + m[j] * rs * gg; s2 += (x[j].x * x[j].x + x[j].y * x[j].y) + (x[j].z * x[j].z + x[j].w * x[j].w);
            *((GAS f32x4*)xdst + lane + 64 * j) = x[j]; }
        if (MODE == 3) continue;
        const float rs2 = rsqrtf(wave_sum(s2) * (1.f / D) + RMS_EPS);
        v2u o[4];
#pragma unroll
        for (int j = 0; j < 4; ++j) { const f32x4 gg = *((const GAS f32x4*)gb + lane + 64 * j);
            o[j].x = pk2(x[j].x * rs2 * gg.x, x[j].y * rs2 * gg.y); o[j].y = pk2(x[j].z * rs2 * gg.z, x[j].w * rs2 * gg.w); }
        if (MODE == 1) {
            if (r < R_META) { const int b = r >> 11, jt = r & 2047, rb = b * 129 + 1 + (jt >> 4), s = jt & 15;
#pragma unroll
                for (int j = 0; j < 4; ++j) *(GAS v2u*)(XNS + (((size_t)rb * 64 + 16 * j + (lane >> 2)) * 16 + s) * 16 + 4 * (lane & 3)) = o[j]; }
            else if (r < R_SMP) { const int s = r - R_META;
                for (int b = 0; b < NBATCH; ++b)
#pragma unroll
                    for (int j = 0; j < 4; ++j) *(GAS v2u*)(XNS + (((size_t)(b * 129) * 64 + 16 * j + (lane >> 2)) * 16 + s) * 16 + 4 * (lane & 3)) = o[j]; }
            else { const int rb = 1032 + (r - R_SMP);
#pragma unroll
                for (int j = 0; j < 4; ++j) *(GAS v2u*)(XNS + (((size_t)rb * 64 + 16 * j + (lane >> 2)) * 16 + 0) * 16 + 4 * (lane & 3)) = o[j];
                GAS v2u* zb = (GAS v2u*)(XNS + (size_t)rb * 64 * 256);
                for (int e = lane; e < 64 * 60; e += 64) { const int g = e / 60, q = e % 60; zb[g * 64 + 4 + q] = (v2u){0u, 0u}; } }
        } else {
            GAS v2u* o8 = (GAS v2u*)(XN + (size_t)r * D) + lane;
#pragma unroll
            for (int j = 0; j < 4; ++j) o8[64 * j] = o[j];
        }
    }
}

constexpr int L2_XB = 0, L2_XCA = 23552, L2_XCF = 50176, L2_AGG = 101376, L2_CW = 107520;
typedef float f32x2 __attribute__((ext_vector_type(2)));

__device__ __forceinline__ void lru2_block(const Ctx& C) {
    const int b = C.vcu >> 5, h = (C.vcu >> 1) & 15, half = C.vcu & 1;
    const int tid = C.tid, lane = C.lane, w = C.wave, fr = lane & 15, fq = lane >> 4, ch0 = 88 * h;
    LAS bf16* XB = (LAS bf16*)(C.lds + RING_OFF + L2_XB); LAS bf16* XCA = (LAS bf16*)(C.lds + RING_OFF + L2_XCA); LAS float* XCF = (LAS float*)(C.lds + RING_OFF + L2_XCF);
    LAS f32x2* AGG = (LAS f32x2*)(C.lds + RING_OFF + L2_AGG); LAS float* CW = (LAS float*)(C.lds + RING_OFF + L2_CW);
    const bf16* XG = (const bf16*)(C.ws + WS_R1); bf16* A2 = (bf16*)(C.ws + WS_R2);
    float ba[3], bx[3], c1[3]; int chg[3], cll[3]; bool valid[3]; bf16x8 bA[3][3], bX[3][3];
    { const bf16* WG = (const bf16*)(C.ws + WS_WGT);
#pragma unroll
      for (int nt = 0; nt < 3; ++nt) { const int cl = 48 * half + 16 * nt + fr; valid[nt] = cl < 88; cll[nt] = cl < 88 ? cl : 87; chg[nt] = ch0 + cll[nt];
          ba[nt] = C.in[I_LBA][chg[nt]]; bx[nt] = C.in[I_LBX][chg[nt]]; c1[nt] = -8.0f * 1.442695041f * log1pf(expf(-C.in[I_LLAM][chg[nt]]));
#pragma unroll
          for (int ks = 0; ks < 3; ++ks) { bA[nt][ks] = *(const GAS bf16x8*)(WG + ((size_t)(h * 2 + 0) * 96 + cl) * 96 + ks * 32 + fq * 8);
              bX[nt][ks] = *(const GAS bf16x8*)(WG + ((size_t)(h * 2 + 1) * 96 + cl) * 96 + ks * 32 + fq * 8); } } }
    __syncthreads();
    for (int e = tid; e < 5 * 96; e += 512) { const int k = e / 96, i = e % 96; float v = 0.f;
        if (i < 88) v = (k < 4) ? C.in[I_LWCONV][k * DR + ch0 + i] : C.in[I_LBCONV][ch0 + i];
        CW[e] = v; }
    for (int e = tid; e < 128 * 16; e += 512) XCA[(e >> 4) * 104 + 88 + (e & 15)] = 0;
#define LRU_ROW(t) (((t) < NMETA) ? (size_t)(R_META + (t)) : (size_t)b * SEQ + (size_t)((t) - NMETA))
#define LRU_LOAD(c, pf) do { _Pragma("unroll") for (int q = 0; q < 3; ++q) { const int e = tid + 512 * q; (pf)[q] = (v4u){0u, 0u, 0u, 0u}; \
        if (e < 131 * 11) { const int rr = e / 11, pc = e % 11, t = 128 * (c) - 3 + rr; if (t >= 0 && t < NMETA + SEQ) (pf)[q] = *(const GAS v4u*)(XG + LRU_ROW(t) * 2816 + ch0 + pc * 8); } } } while (0)
#define LRU_PUT(pf) do { _Pragma("unroll") for (int q = 0; q < 3; ++q) { const int e = tid + 512 * q; if (e < 131 * 11) { const int rr = e / 11, pc = e % 11; *(LAS v4u*)(XB + rr * 88 + pc * 8) = (pf)[q]; } } } while (0)
    { v4u pf[3]; LRU_LOAD(0, pf); LRU_PUT(pf); }
    __syncthreads();
    float hc[3] = {0.f, 0.f, 0.f};
    for (int c = 0; c < 17; ++c) {
        const int nvw = (c < 16) ? 8 : 1;
        v4u pf[3];
        if (c < 16) LRU_LOAD(c + 1, pf);
#pragma unroll
        for (int q = 0; q < 3; ++q) { const int e = tid + 512 * q;
            if (e < 11 * 128) { const int pc = e >> 7, tl = e & 127; float acc[8];
                { const f32x4 b0 = *(const LAS f32x4*)(CW + 4 * 96 + pc * 8), b1 = *(const LAS f32x4*)(CW + 4 * 96 + pc * 8 + 4);
                  acc[0] = b0.x; acc[1] = b0.y; acc[2] = b0.z; acc[3] = b0.w; acc[4] = b1.x; acc[5] = b1.y; acc[6] = b1.z; acc[7] = b1.w; }
#pragma unroll
                for (int k = 0; k < 4; ++k) { const v4u xv = *(const LAS v4u*)(XB + (tl + k) * 88 + pc * 8);
                    const f32x4 w0 = *(const LAS f32x4*)(CW + k * 96 + pc * 8), w1 = *(const LAS f32x4*)(CW + k * 96 + pc * 8 + 4);
                    acc[0] += w0.x * bflo(xv.x); acc[1] += w0.y * bfhi(xv.x); acc[2] += w0.z * bflo(xv.y); acc[3] += w0.w * bfhi(xv.y);
                    acc[4] += w1.x * bflo(xv.z); acc[5] += w1.y * bfhi(xv.z); acc[6] += w1.z * bflo(xv.w); acc[7] += w1.w * bfhi(xv.w); }
                v4u o; o.x = pk2(acc[0], acc[1]); o.y = pk2(acc[2], acc[3]); o.z = pk2(acc[4], acc[5]); o.w = pk2(acc[6], acc[7]);
                *(LAS v4u*)(XCA + tl * 104 + pc * 8) = o;
                *(LAS f32x4*)(XCF + tl * 100 + pc * 8) = (f32x4){acc[0], acc[1], acc[2], acc[3]}; *(LAS f32x4*)(XCF + tl * 100 + pc * 8 + 4) = (f32x4){acc[4], acc[5], acc[6], acc[7]}; } }
        __syncthreads();
        float A_[3][4], B_[3][4], cA[3], cB[3], gg[3][4];
        {
            bf16x8 a[3];
#pragma unroll
            for (int ks = 0; ks < 3; ++ks) a[ks] = *(const LAS bf16x8*)(XCA + (16 * w + fr) * 104 + ks * 32 + fq * 8);
#pragma unroll
            for (int nt = 0; nt < 3; ++nt) {
                if (w < nvw) {
#pragma unroll
                    for (int j = 0; j < 4; ++j) { const int t = 128 * c + 16 * w + 4 * fq + j; gg[nt][j] = bf2f(XG[LRU_ROW(t) * 2816 + DR + chg[nt]]); } }
                f32x4 accR = {0.f, 0.f, 0.f, 0.f}, accI = {0.f, 0.f, 0.f, 0.f};
#pragma unroll
                for (int ks = 0; ks < 3; ++ks) { accR = __builtin_amdgcn_mfma_f32_16x16x32_bf16(a[ks], bA[nt][ks], accR, 0, 0, 0);
                    accI = __builtin_amdgcn_mfma_f32_16x16x32_bf16(a[ks], bX[nt][ks], accI, 0, 0, 0); }
                float av[4], bv[4];
#pragma unroll
                for (int j = 0; j < 4; ++j) { const float xc = XCF[(16 * w + 4 * fq + j) * 100 + cll[nt]];
                    const float r = sigmoid_f(accR[j] + ba[nt]), ig = sigmoid_f(accI[j] + bx[nt]);
                    const float aa = __builtin_amdgcn_exp2f(c1[nt] * r);
                    const float om = __builtin_fmaf(-aa, aa, 1.0f);
                    av[j] = aa; bv[j] = __builtin_amdgcn_sqrtf(om > 0.f ? om : 0.f) * (ig * xc); }
                A_[nt][0] = av[0]; B_[nt][0] = bv[0];
#pragma unroll
                for (int j = 1; j < 4; ++j) { A_[nt][j] = av[j] * A_[nt][j - 1]; B_[nt][j] = av[j] * B_[nt][j - 1] + bv[j]; }
                const float tA = A_[nt][3], tB = B_[nt][3];
                const float gA0 = __shfl(tA, fr), gB0 = __shfl(tB, fr), gA1 = __shfl(tA, fr + 16), gB1 = __shfl(tB, fr + 16);
                const float gA2 = __shfl(tA, fr + 32), gB2 = __shfl(tB, fr + 32), gA3 = __shfl(tA, fr + 48), gB3 = __shfl(tB, fr + 48);
                const float c2A = gA1 * gA0, c2B = gA1 * gB0 + gB1, c3A = gA2 * c2A, c3B = gA2 * c2B + gB2;
                float tilA = gA3 * c3A, tilB = gA3 * c3B + gB3;
                cA[nt] = fq == 0 ? 1.f : (fq == 1 ? gA0 : (fq == 2 ? c2A : c3A)); cB[nt] = fq == 0 ? 0.f : (fq == 1 ? gB0 : (fq == 2 ? c2B : c3B));
                if (w >= nvw) { tilA = 1.f; tilB = 0.f; }
                if (fq == 0) AGG[((c & 1) * 8 + w) * 48 + nt * 16 + fr] = (f32x2){tilA, tilB};
            }
        }
        __syncthreads();
#pragma unroll
        for (int nt = 0; nt < 3; ++nt) { float hcur = hc[nt], hst = hc[nt];
#pragma unroll
            for (int ww = 0; ww < 8; ++ww) { const f32x2 ag = AGG[((c & 1) * 8 + ww) * 48 + nt * 16 + fr]; if (ww == w) hst = hcur; hcur = ag.y + ag.x * hcur; }
            hc[nt] = hcur;
            if (w < nvw) { const float hb = cB[nt] + cA[nt] * hst;
#pragma unroll
                for (int j = 0; j < 4; ++j) { const float hj = B_[nt][j] + A_[nt][j] * hb; const int t = 128 * c + 16 * w + 4 * fq + j;
                    if (valid[nt] && (b == 0 || t >= NMETA)) A2[LRU_ROW(t) * DR + chg[nt]] = (bf16)f2bf(hj * gg[nt][j]); } } }
        if (c < 16) LRU_PUT(pf);
        __syncthreads();
    }
    if (w == 0 && fq == 0) {
#pragma unroll
        for (int nt = 0; nt < 3; ++nt) if (valid[nt]) C.out[O_LHP + (size_t)b * DR + chg[nt]] = hc[nt]; }
    if (tid < 3 * 48) { const int k = tid / 48, cl = 48 * half + tid % 48;
        if (cl < 88) C.out[O_LCP + ((size_t)b * 3 + k) * DR + ch0 + cl] = bf2f(XG[((size_t)b * SEQ + (SEQ - 3 + k)) * 2816 + ch0 + cl]); }
    if (b == 0) {
        const float* cs = C.in[I_LC]; const float* h0 = C.in[I_LH];
#pragma unroll
        for (int q = 0; q < 3; ++q) { const int e = tid + 512 * q;
            if (e < 11 * 128) { const int pc = e >> 7, i = e & 127, c8 = ch0 + pc * 8; float acc[8], xs[4][8];
                { const v4u xv = *(const GAS v4u*)(XG + (size_t)(R_SMP + i) * 2816 + c8);
                  xs[3][0] = bflo(xv.x); xs[3][1] = bfhi(xv.x); xs[3][2] = bflo(xv.y); xs[3][3] = bfhi(xv.y); xs[3][4] = bflo(xv.z); xs[3][5] = bfhi(xv.z); xs[3][6] = bflo(xv.w); xs[3][7] = bfhi(xv.w); }
#pragma unroll
                for (int k = 0; k < 3; ++k) { const f32x4 s0 = *(const GAS f32x4*)(cs + ((size_t)i * 3 + k) * DR + c8), s1 = *(const GAS f32x4*)(cs + ((size_t)i * 3 + k) * DR + c8 + 4);
                    xs[k][0] = s0.x; xs[k][1] = s0.y; xs[k][2] = s0.z; xs[k][3] = s0.w; xs[k][4] = s1.x; xs[k][5] = s1.y; xs[k][6] = s1.z; xs[k][7] = s1.w; }
#pragma unroll
                for (int u = 0; u < 8; ++u) { acc[u] = CW[4 * 96 + pc * 8 + u];
#pragma unroll
                    for (int k = 0; k < 4; ++k) acc[u] += CW[k * 96 + pc * 8 + u] * xs[k][u]; }
                v4u o; o.x = pk2(acc[0], acc[1]); o.y = pk2(acc[2], acc[3]); o.z = pk2(acc[4], acc[5]); o.w = pk2(acc[6], acc[7]);
                *(LAS v4u*)(XCA + i * 104 + pc * 8) = o;
                *(LAS f32x4*)(XCF + i * 100 + pc * 8) = (f32x4){acc[0], acc[1], acc[2], acc[3]}; *(LAS f32x4*)(XCF + i * 100 + pc * 8 + 4) = (f32x4){acc[4], acc[5], acc[6], acc[7]};
                if (half == 0) {
#pragma unroll
                    for (int k = 0; k < 3; ++k) { float* op = C.out + O_LCS + ((size_t)i * 3 + k) * DR + c8;
                        *(GAS f32x4*)op = (f32x4){xs[k + 1][0], xs[k + 1][1], xs[k + 1][2], xs[k + 1][3]}; *(GAS f32x4*)(op + 4) = (f32x4){xs[k + 1][4], xs[k + 1][5], xs[k + 1][6], xs[k + 1][7]}; } } } }
        __syncthreads();
        bf16x8 a[3];
#pragma unroll
        for (int ks = 0; ks < 3; ++ks) a[ks] = *(const LAS bf16x8*)(XCA + (16 * w + fr) * 104 + ks * 32 + fq * 8);
#pragma unroll
        for (int nt = 0; nt < 3; ++nt) {
            f32x4 accR = {0.f, 0.f, 0.f, 0.f}, accI = {0.f, 0.f, 0.f, 0.f};
#pragma unroll
            for (int ks = 0; ks < 3; ++ks) { accR = __builtin_amdgcn_mfma_f32_16x16x32_bf16(a[ks], bA[nt][ks], accR, 0, 0, 0);
                accI = __builtin_amdgcn_mfma_f32_16x16x32_bf16(a[ks], bX[nt][ks], accI, 0, 0, 0); }
#pragma unroll
            for (int j = 0; j < 4; ++j) { const int i = 16 * w + 4 * fq + j; const float xc = XCF[i * 100 + cll[nt]];
                const float r = sigmoid_f(accR[j] + ba[nt]), ig = sigmoid_f(accI[j] + bx[nt]);
                const float aa = __builtin_amdgcn_exp2f(c1[nt] * r);
                const float om = __builtin_fmaf(-aa, aa, 1.0f);
                const float bb = __builtin_amdgcn_sqrtf(om > 0.f ? om : 0.f) * (ig * xc);
                const float hn = aa * h0[(size_t)i * DR + chg[nt]] + bb;
                const float g1 = bf2f(XG[(size_t)(R_SMP + i) * 2816 + DR + chg[nt]]);
                if (valid[nt]) { A2[(size_t)(R_SMP + i) * DR + chg[nt]] = (bf16)f2bf(hn * g1); C.out[O_LHS + (size_t)i * DR + chg[nt]] = hn; } }
        }
    }
#undef LRU_ROW
#undef LRU_LOAD
#undef LRU_PUT
}

constexpr int S5_EB = 0, S5_HB = 76032;
__device__ __forceinline__ void s5_item(const Ctx& C, int it) {
    const int tid = C.tid, lane = C.lane, wave = C.wave, fr = lane & 15, fq = lane >> 4;
    const bool smp = it >= 512; const int g = smp ? it - 512 : (it & 63), b = smp ? 0 : (it >> 6);
    const int rb0 = smp ? 1032 : b * 129, nrow = smp ? 128 : 129, nm = smp ? 8 : 9;
    LAS float* EB = (LAS float*)(C.lds + RING_OFF + S5_EB); LAS bf16* HB = (LAS bf16*)(C.lds + RING_OFF + S5_HB);
    const bf16* U = (const bf16*)(C.ws + WS_R1) + ((size_t)rb0 * 64 + g) * 256;
    const bf16* WE = (const bf16*)(C.ws + WS_S5WE) + (size_t)g * 128 * 256; const bf16* WY = (const bf16*)(C.ws + WS_S5WY) + (size_t)g * 256 * 384;
    const float* S5C = (const float*)(C.ws + WS_S5C); bf16* Z = (bf16*)(C.ws + WS_R2);
    __syncthreads();
    { bf16x8 bE[8];
#pragma unroll
      for (int ks = 0; ks < 8; ++ks) bE[ks] = *(const GAS bf16x8*)(WE + (size_t)(16 * wave + fr) * 256 + ks * 32 + fq * 8);
      for (int m = 0; m < nm; ++m) { f32x4 acc = {0.f, 0.f, 0.f, 0.f}; const bf16* ar = U + (size_t)(16 * m + fr) * 16384 + fq * 8;
#pragma unroll
          for (int ks = 0; ks < 8; ++ks) { const bf16x8 a = *(const GAS bf16x8*)(ar + ks * 32); acc = __builtin_amdgcn_mfma_f32_16x16x32_bf16(a, bE[ks], acc, 0, 0, 0); }
#pragma unroll
          for (int j = 0; j < 4; ++j) EB[(16 * m + 4 * fq + j) * 132 + 16 * wave + fr] = acc[j]; } }
    __syncthreads();
    if (!smp) {
        if (wave == 0) { const int p = lane; const float ar = S5C[0 * 4096 + g * 64 + p], ai = S5C[1 * 4096 + g * 64 + p]; float hr = 0.f, hi = 0.f;
            for (int k0 = 0; k0 < 129; k0 += 8) { float er[8], ei[8];
#pragma unroll
                for (int q = 0; q < 8; ++q) { const int k = (k0 + q) < 129 ? (k0 + q) : 128; er[q] = EB[k * 132 + p]; ei[q] = EB[k * 132 + 64 + p]; }
#pragma unroll
                for (int q = 0; q < 8; ++q) { const int k = k0 + q; if (k < 129) { HB[k * 136 + p] = (bf16)f2bf(hr); HB[k * 136 + 64 + p] = (bf16)f2bf(hi);
                        const float nr = ar * hr - ai * hi + er[q], ni = ar * hi + ai * hr + ei[q]; hr = nr; hi = ni; } } }
            C.out[O_SRP + ((size_t)b * 64 + g) * 64 + p] = hr; C.out[O_SIP + ((size_t)b * 64 + g) * 64 + p] = hi; }
    } else {
        for (int e = tid; e < 128 * 64; e += 512) { const int i = e >> 6, p = e & 63;
            const float h0r = C.in[I_SRE][((size_t)i * 64 + g) * 64 + p], h0i = C.in[I_SIM][((size_t)i * 64 + g) * 64 + p];
            HB[i * 136 + p] = (bf16)f2bf(h0r); HB[i * 136 + 64 + p] = (bf16)f2bf(h0i);
            const float er = EB[i * 132 + p], ei = EB[i * 132 + 64 + p];
            const float a1r = S5C[2 * 4096 + g * 64 + p], a1i = S5C[3 * 4096 + g * 64 + p], mr = S5C[4 * 4096 + g * 64 + p], mi = S5C[5 * 4096 + g * 64 + p];
            C.out[O_SRS + ((size_t)i * 64 + g) * 64 + p] = a1r * h0r - a1i * h0i + (mr * er - mi * ei);
            C.out[O_SIS + ((size_t)i * 64 + g) * 64 + p] = a1r * h0i + a1i * h0r + (mr * ei + mi * er); }
    }
    __syncthreads();
    { bf16x8 bY[2][12];
#pragma unroll
      for (int nt = 0; nt < 2; ++nt)
#pragma unroll
          for (int ks = 0; ks < 12; ++ks) bY[nt][ks] = *(const GAS bf16x8*)(WY + (size_t)(16 * (2 * wave + nt) + fr) * 384 + ks * 32 + fq * 8);
      const float dsk = C.in[I_SD][16 * g + fr];
      for (int m = 0; m < nm; ++m) { f32x4 acc[2] = {{0.f, 0.f, 0.f, 0.f}, {0.f, 0.f, 0.f, 0.f}}; const bf16* ar = U + (size_t)(16 * m + fr) * 16384 + fq * 8;
#pragma unroll
          for (int ks = 0; ks < 12; ++ks) { bf16x8 a;
              if (ks < 8) a = *(const GAS bf16x8*)(ar + ks * 32); else a = *(const LAS bf16x8*)(HB + (16 * m + fr) * 136 + (ks - 8) * 32 + fq * 8);
              acc[0] = __builtin_amdgcn_mfma_f32_16x16x32_bf16(a, bY[0][ks], acc[0], 0, 0, 0);
              acc[1] = __builtin_amdgcn_mfma_f32_16x16x32_bf16(a, bY[1][ks], acc[1], 0, 0, 0); }
#pragma unroll
          for (int nt = 0; nt < 2; ++nt) { const int t = 2 * wave + nt;
#pragma unroll
              for (int j = 0; j < 4; ++j) { const int rl = 16 * m + 4 * fq + j;
                  if (rl < nrow) { const float xnv = bf2f(U[(size_t)rl * 16384 + t * 16 + fr]);
                      const float z = gelu_tanh_f(acc[nt][j] + dsk * xnv);
                      long row = -1;
                      if (smp) { if (t == 0) row = R_SMP + rl; }
                      else if (rl == 0) { if (b == 0) row = R_META + t; }
                      else row = (long)b * SEQ + 16 * (rl - 1) + t;
                      if (row >= 0) Z[(size_t)row * D + 16 * g + fr] = (bf16)f2bf(z); } } } } }
}

constexpr int N_PHASES = 14;
#ifndef DUP_MASK
#define DUP_MASK 0
#endif
#define NREP(k) (((DUP_MASK >> (k)) & 1) ? 2 : 1)
__global__ void __launch_bounds__(NWAVES * 64, 2) hybrid_fwd(Args args) {
    extern __shared__ __attribute__((aligned(16))) unsigned char lds_raw[];
    Ctx C;
    C.lds = (LAS unsigned char*)lds_raw;
    C.tid = threadIdx.x; C.lane = C.tid & 63; C.wave = __builtin_amdgcn_readfirstlane(C.tid >> 6);
    C.G = gridDim.x; { const int bx = blockIdx.x; C.vcu = (C.G % 8 == 0) ? (bx % 8) * (C.G / 8) + bx / 8 : bx; }
    C.in = args.in; C.out = args.out; C.ws = args.ws;
    volatile LAS unsigned* MISC = (volatile LAS unsigned*)(C.lds + MISC_OFF);
    for (int u = C.tid; u < (LDS_BYTES - LDSCTL_OFF) / 4; u += NWAVES * 64) ((LAS unsigned*)(C.lds + LDSCTL_OFF))[u] = 0u;
    __syncthreads();
    const int lo = args.ph_lo, hi = args.ph_hi;
    XcdBarrier bar; bar.bar = (unsigned*)(C.ws + WS_CTL) + CW_BAR; bar.x = 0; bar.st = nullptr;
    if (hi - lo > 1) bar = xcd_barrier_post((unsigned*)(C.ws + WS_CTL) + CW_BAR, MISC + 8);
#define IN(k) (lo <= (k) && (k) < hi)
#define SEAM(k) do { if (IN(k) && IN((k) + 1)) xcd_barrier(bar); } while (0)
    const float* gain = args.in[I_GAIN];
    bf16* XN = (bf16*)(C.ws + WS_XN); bf16* R1 = (bf16*)(C.ws + WS_R1); bf16* R2 = (bf16*)(C.ws + WS_R2);

    if (IN(0)) { p0_prologue(C); } SEAM(0);
    if (IN(1)) {
        pg8::Gemm g{XN, (const bf16*)(C.ws + WS_W1T), MROWS, 2816, 1024, 1024}; pg8::StaticOrder S; S.init(MROWS, 2816, C.G, (int)blockIdx.x);
        pg8::EpiXG E{R1};
        pg8::gemm_phase<pg8::EpiXG, pg8::StaticOrder, PG8_ALIGN, PG8_SP2>(C.lds + RING_OFF, g, S, E);
    } SEAM(1);
    if (IN(2)) {
        lru2_block(C);
    } SEAM(2);
    if (IN(3)) {
        pg8::Gemm g{R2, (const bf16*)(C.ws + WS_W2T), 16384, 1024, 1408, 1408}; pg8::StaticOrder S; S.init(16384, 1024, C.G, (int)blockIdx.x);
        pg8::EpiPlain E{R1, 1024};
        pg8::gemm_phase<pg8::EpiPlain, pg8::StaticOrder, PG8_ALIGN, PG8_SP2>(C.lds + RING_OFF, g, S, E);
        pg8::Gemm g2{R2, (const bf16*)(C.ws + WS_W2T), MROWS, 1024, 128, 1408}; pg8::SplitOrder S2{4, 11, 128, C.G, (int)blockIdx.x, 64};
        pg8::EpiSlab E2{(float*)(C.ws + WS_SLAB), 1024};
        pg8::gemm_phase<pg8::EpiSlab, pg8::SplitOrder, PG8_ALIGN, PG8_SP2>(C.lds + RING_OFF, g2, S2, E2);
    } SEAM(3);
    if (IN(4)) { nr_phase<0>(C, R1, gain + 1 * D, gain + 2 * D, 11, 1024, false); } SEAM(4);
    if (IN(5)) {
        pg8::Gemm g{XN, (const bf16*)(C.ws + WS_W3T), MROWS, 5632, 1024, 1024}; pg8::StaticOrder S; S.init(MROWS, 5632, C.G, (int)blockIdx.x);
        pg8::EpiGated<0> E{R1, 2816};
        pg8::gemm_phase<pg8::EpiGated<0>, pg8::StaticOrder, PG8_ALIGN, PG8_SP2>(C.lds + RING_OFF, g, S, E);
    } SEAM(5);
    if (IN(6)) {
        pg8::Gemm g{R1, (const bf16*)(C.ws + WS_W4T), 16384, 1024, 2816, 2816}; pg8::StaticOrder S; S.init(16384, 1024, C.G, (int)blockIdx.x);
        pg8::EpiPlain E{R2, 1024};
        pg8::gemm_phase<pg8::EpiPlain, pg8::StaticOrder, PG8_ALIGN, PG8_SP2>(C.lds + RING_OFF, g, S, E);
        pg8::Gemm g2{R1, (const bf16*)(C.ws + WS_W4T), MROWS, 1024, 256, 2816}; pg8::SplitOrder S2{4, 11, 256, C.G, (int)blockIdx.x, 64};
        pg8::EpiSlab E2{(float*)(C.ws + WS_SLAB), 1024};
        pg8::gemm_phase<pg8::EpiSlab, pg8::SplitOrder, PG8_ALIGN, PG8_SP2>(C.lds + RING_OFF, g2, S2, E2);
    } SEAM(6);
    if (IN(7)) { nr_phase<1>(C, R2, gain + 3 * D, gain + 4 * D, 11, 1024, false); } SEAM(7);
    if (IN(8)) {
        for (int it = C.vcu; it < 576; it += C.G) s5_item(C, it);
    } SEAM(8);
    if (IN(9)) {
        pg8::Gemm g{R2, (const bf16*)(C.ws + WS_W5T), 16384, 2048, 1024, 1024}; pg8::StaticOrder S; S.init(16384, 2048, C.G, (int)blockIdx.x);
        pg8::EpiGated<1> E{R1, 1024};
        pg8::gemm_phase<pg8::EpiGated<1>, pg8::StaticOrder, PG8_ALIGN, PG8_SP2>(C.lds + RING_OFF, g, S, E);
        pg8::Gemm g2{R2, (const bf16*)(C.ws + WS_W5T), MROWS, 2048, 256, 1024}; pg8::SplitOrder S2{8, 4, 256, C.G, (int)blockIdx.x, 64};
        pg8::EpiSlab E2{(float*)(C.ws + WS_SLAB), 2048};
        pg8::gemm_phase<pg8::EpiSlab, pg8::SplitOrder, PG8_ALIGN, PG8_SP2>(C.lds + RING_OFF, g2, S2, E2);
    } SEAM(9);
    if (IN(10)) { nr_phase<2>(C, R1, gain + 5 * D, gain + 6 * D, 4, 2048, true); } SEAM(10);
    if (IN(11)) {
        pg8::Gemm g{XN, (const bf16*)(C.ws + WS_W3T) + (size_t)5632 * 1024, MROWS, 5632, 1024, 1024}; pg8::StaticOrder S; S.init(MROWS, 5632, C.G, (int)blockIdx.x);
        pg8::EpiGated<0> E{R1, 2816};
        pg8::gemm_phase<pg8::EpiGated<0>, pg8::StaticOrder, PG8_ALIGN, PG8_SP2>(C.lds + RING_OFF, g, S, E);
    } SEAM(11);
    if (IN(12)) {
        pg8::Gemm g{R1, (const bf16*)(C.ws + WS_W4T) + (size_t)1024 * 2816, 16384, 1024, 2816, 2816}; pg8::StaticOrder S; S.init(16384, 1024, C.G, (int)blockIdx.x);
        pg8::EpiPlain E{R2, 1024};
        pg8::gemm_phase<pg8::EpiPlain, pg8::StaticOrder, PG8_ALIGN, PG8_SP2>(C.lds + RING_OFF, g, S, E);
        pg8::Gemm g2{R1, (const bf16*)(C.ws + WS_W4T) + (size_t)1024 * 2816, MROWS, 1024, 256, 2816}; pg8::SplitOrder S2{4, 11, 256, C.G, (int)blockIdx.x, 64};
        pg8::EpiSlab E2{(float*)(C.ws + WS_SLAB), 1024};
        pg8::gemm_phase<pg8::EpiSlab, pg8::SplitOrder, PG8_ALIGN, PG8_SP2>(C.lds + RING_OFF, g2, S2, E2);
    } SEAM(12);
    if (IN(13)) { nr_phase<3>(C, R2, gain + 7 * D, gain, 11, 1024, false); }
#undef IN
#undef SEAM
}

#ifndef MK_ONE_LAUNCH
#define MK_ONE_LAUNCH 1
#endif
extern "C" void kernel_launch(void* const* d_in, const int* in_sizes, int n_in, void* d_out, int out_size, void* d_ws, size_t ws_size, hipStream_t stream) {
    static int grid = 0;
    if (grid == 0) {
        if (n_in != 28 || out_size != (int)O_END || ws_size < WS_END) { fprintf(stderr, "kernel_launch: unexpected shapes: n_in %d out %d ws %zu (need %zu)\n", n_in, out_size, ws_size, (size_t)WS_END); grid = -1; return; }
        int dev = 0, cus = 0, per_cu = 0;
        if (hipGetDevice(&dev) != hipSuccess || hipDeviceGetAttribute(&cus, hipDeviceAttributeMultiprocessorCount, dev) != hipSuccess) { grid = -1; return; }
        if (hipFuncSetAttribute((const void*)hybrid_fwd, hipFuncAttributeMaxDynamicSharedMemorySize, LDS_BYTES) != hipSuccess) { fprintf(stderr, "kernel_launch: hipFuncSetAttribute failed\n"); grid = -1; return; }
        if (hipOccupancyMaxActiveBlocksPerMultiprocessor(&per_cu, (const void*)hybrid_fwd, NWAVES * 64, LDS_BYTES) != hipSuccess || per_cu < 1) { fprintf(stderr, "kernel_launch: occupancy query says %d\n", per_cu); }
        (void)hipGetLastError();
        grid = cus;
        if (grid != 256) fprintf(stderr, "kernel_launch: %d CUs (built for 256)\n", grid);
    }
    if (grid < 0) return;
    (void)in_sizes;
    if (hipMemsetAsync((char*)d_ws + WS_CTL, 0, CTL_ZERO_BYTES, stream) != hipSuccess) return;
    Args a{};
    for (int i = 0; i < 28; ++i) a.in[i] = (const float*)d_in[i];
    a.out = (float*)d_out; a.ws = (unsigned char*)d_ws;
#if MK_ONE_LAUNCH
    a.ph_lo = 0; a.ph_hi = N_PHASES;
    hipLaunchKernelGGL(hybrid_fwd, dim3(grid), dim3(NWAVES * 64), LDS_BYTES, stream, a);
#else
    for (int p = 0; p < N_PHASES; ++p) for (int rep = 0; rep < NREP(p); ++rep) { a.ph_lo = p; a.ph_hi = p + 1;
        hipLaunchKernelGGL(hybrid_fwd, dim3(grid), dim3(NWAVES * 64), LDS_BYTES, stream, a); }
#endif
}
```

```cpp
#include <hip/hip_runtime.h>
#include <cstdio>
#include <cstdint>
namespace pg8 {
#define PG8_LAS __attribute__((address_space(3)))
typedef unsigned short bf16_t;
typedef short bf16x8 __attribute__((ext_vector_type(8)));
typedef float f32x4 __attribute__((ext_vector_type(4)));
typedef unsigned u32x4 __attribute__((ext_vector_type(4)));
constexpr int BM = 256, BK = 64, HALF = 128, HTB = HALF * BK * 2  , STAGE_BYTES = 8 * HTB, NXCD = 8, WGM = 8;

__host__ __device__ __forceinline__ int lds_byte(int r, int c) { const int st = (r >> 4) * 2 + (c >> 5), rr = r & 15, cc = c & 31, ob = rr * 64 + cc * 2; return st * 1024 + (ob ^ (((ob >> 9) & 1) << 5)); }
__host__ __device__ __forceinline__ void stage_rc(int b, int& R, int& C) { const int st = b / 1024, sb = b % 1024, swz = sb ^ (((sb >> 9) & 1) << 5); R = (st >> 1) * 16 + swz / 64; C = (st & 1) * 32 + (swz % 64) / 2; }
__host__ __device__ __forceinline__ int perm32(int rho) { const int n = rho >> 4, i = rho & 15; return 8 * (i >> 2) + 4 * n + (i & 3); }

struct Unit { int pm, pn, koff, ks; };
struct Gemm { const bf16_t* A; const bf16_t* Bt; int M, N, K, ld; };

struct StaticOrder {
    int nM, nN, nwg, G, c;
    __host__ __device__ void init(int M, int N, int G_, int c_) { nM = M / BM; nN = N / BM; nwg = nM * nN; G = G_; c = c_; }
    __host__ __device__ bool next(int i, Unit& u) const {
        const long L = (long)i * G + c; if (L >= nwg) return false;
        int wgid = (int)L; { const int q = nwg / NXCD, r = nwg % NXCD, xcd = wgid % NXCD, off = wgid / NXCD; wgid = (xcd < r ? xcd * (q + 1) : r * (q + 1) + (xcd - r) * q) + off; }
        const int nig = WGM * nN, gid = wgid / nig, fm = gid * WGM, gsz = (nM - fm) < WGM ? (nM - fm) : WGM;
        u.pm = fm + ((wgid % nig) % gsz); u.pn = (wgid % nig) / gsz; u.koff = 0; u.ks = 0; return true;
    }
    __device__ __forceinline__ void a_ready(const Unit&) const {}
    __device__ __forceinline__ void done(const Unit&) const {}
};

__device__ __forceinline__ unsigned cvt_pk_bf16(float lo, float hi) { unsigned r; asm volatile("v_cvt_pk_bf16_f32 %0, %1, %2" : "=v"(r) : "v"(lo), "v"(hi)); return r; }
typedef float f32x2 __attribute__((ext_vector_type(2)));
__device__ __forceinline__ f32x2 gelu_pk(f32x2 v) {
    const f32x2 av = __builtin_elementwise_abs(v), d = av * 0.2316418882f + 1.0f;
    f32x2 t; t.x = __builtin_amdgcn_rcpf(d.x); t.y = __builtin_amdgcn_rcpf(d.y);
    f32x2 q = t * 0.5307027145f + (-0.7265760135f); q = q * t + 0.7107068705f; q = q * t + (-0.142248368f); q = q * t + 0.127414796f; q = q * t;
    const f32x2 s = (v * v) * (-0.72134752044f);
    f32x2 e; e.x = __builtin_amdgcn_exp2f(s.x); e.y = __builtin_amdgcn_exp2f(s.y);
    const f32x2 m = v * (q * e), r = v - m;
    f32x2 o; o.x = v.x < 0.f ? m.x : r.x; o.y = v.y < 0.f ? m.y : r.y; return o;
}

template <int ACT  > struct EpiBf16 {
    static constexpr bool PERM = true, AFTER_DRAIN = false; static_assert(ACT == 0 || ACT == 1, "EpiBf16: ACT is 0 (none) or 1 (gelu_pk)");
    bf16_t* O; int ldc; const float* bias; int split_cols; size_t split_stride; float scale0;
    __device__ __forceinline__ void operator()(const f32x4 (&acc)[2][2][4][2], const Unit& u, int wr, int wc, int fr, int fq) const {
        const int row0 = u.pm * BM + wr * 64 + fr; int colt = u.pn * BM; bf16_t* base = O;
        float sc = 1.f; if (split_cols) { const int t = colt / split_cols; base += (size_t)t * split_stride; colt -= t * split_cols; if (t == 0) sc = scale0; }
        const int col0 = colt + wc * 32 + 8 * fq, bcol0 = u.pn * BM + wc * 32 + 8 * fq;
        f32x4 bv[2][2];
#pragma unroll
        for (int bj = 0; bj < 2; ++bj)
#pragma unroll
            for (int n = 0; n < 2; ++n) bv[bj][n] = bias ? *(const f32x4*)(bias + bcol0 + bj * HALF + 4 * n) : (f32x4){0.f, 0.f, 0.f, 0.f};
#pragma unroll
        for (int ai = 0; ai < 2; ++ai)
#pragma unroll
            for (int m = 0; m < 4; ++m) { bf16_t* rowp = base + (size_t)(row0 + ai * HALF + m * 16) * ldc + col0;
#pragma unroll
                for (int bj = 0; bj < 2; ++bj) { f32x4 v0 = acc[ai][bj][m][0] + bv[bj][0], v1 = acc[ai][bj][m][1] + bv[bj][1];
                    if (ACT == 1) { f32x2 a = gelu_pk((f32x2){v0[0], v0[1]}), b = gelu_pk((f32x2){v0[2], v0[3]}), c = gelu_pk((f32x2){v1[0], v1[1]}), d = gelu_pk((f32x2){v1[2], v1[3]});
                        v0 = (f32x4){a.x, a.y, b.x, b.y}; v1 = (f32x4){c.x, c.y, d.x, d.y}; }
                    v0 = v0 * sc; v1 = v1 * sc; u32x4 w; w.x = cvt_pk_bf16(v0[0], v0[1]); w.y = cvt_pk_bf16(v0[2], v0[3]); w.z = cvt_pk_bf16(v1[0], v1[1]); w.w = cvt_pk_bf16(v1[2], v1[3]);
                    *(u32x4*)(rowp + bj * HALF) = w; } }
    }
};

__device__ __forceinline__ float gelu_tanh_f(float x) {
    const float u = x * (1.0f + 0.044715f * x * x);
    const float e = __builtin_amdgcn_exp2f(-2.302208198f * u);
    return x * __builtin_amdgcn_rcpf(1.0f + e);
}
__device__ __forceinline__ float sigmoid_f(float x) { return __builtin_amdgcn_rcpf(1.0f + __builtin_amdgcn_exp2f(-1.442695041f * x)); }

struct EpiXG {
    static constexpr bool PERM = true, AFTER_DRAIN = false;
    bf16_t* O;
    __device__ __forceinline__ void operator()(const f32x4 (&acc)[2][2][4][2], const Unit& u, int wr, int wc, int fr, int fq) const {
        const int row0 = u.pm * BM + wr * 64 + fr, col0 = u.pn * BM + wc * 32 + 8 * fq;
#pragma unroll
        for (int ai = 0; ai < 2; ++ai)
#pragma unroll
            for (int m = 0; m < 4; ++m) { bf16_t* rowp = O + (size_t)(row0 + ai * HALF + m * 16) * 2816 + col0;
#pragma unroll
                for (int bj = 0; bj < 2; ++bj) { f32x4 v0 = acc[ai][bj][m][0], v1 = acc[ai][bj][m][1];
                    if (u.pn * BM + bj * HALF >= 1408) {
#pragma unroll
                        for (int j = 0; j < 4; ++j) { v0[j] = gelu_tanh_f(v0[j]); v1[j] = gelu_tanh_f(v1[j]); } }
                    u32x4 w; w.x = cvt_pk_bf16(v0[0], v0[1]); w.y = cvt_pk_bf16(v0[2], v0[3]); w.z = cvt_pk_bf16(v1[0], v1[1]); w.w = cvt_pk_bf16(v1[2], v1[3]);
                    *(u32x4*)(rowp + bj * HALF) = w; } }
    }
};
template <int ACT> struct EpiGated {
    static constexpr bool PERM = true, AFTER_DRAIN = false;
    bf16_t* O; int ldc;
    __device__ __forceinline__ void operator()(const f32x4 (&acc)[2][2][4][2], const Unit& u, int wr, int wc, int fr, int fq) const {
        const int row0 = u.pm * BM + wr * 64 + fr, col0 = u.pn * HALF + wc * 32 + 8 * fq;
#pragma unroll
        for (int ai = 0; ai < 2; ++ai)
#pragma unroll
            for (int m = 0; m < 4; ++m) { bf16_t* rowp = O + (size_t)(row0 + ai * HALF + m * 16) * ldc + col0;
                f32x4 o[2];
#pragma unroll
                for (int n = 0; n < 2; ++n)
#pragma unroll
                    for (int j = 0; j < 4; ++j) { const float a = acc[ai][0][m][n][j], b = acc[ai][1][m][n][j];
                        o[n][j] = (ACT == 0) ? (a * sigmoid_f(a)) * b : a * sigmoid_f(b); }
                u32x4 w; w.x = cvt_pk_bf16(o[0][0], o[0][1]); w.y = cvt_pk_bf16(o[0][2], o[0][3]); w.z = cvt_pk_bf16(o[1][0], o[1][1]); w.w = cvt_pk_bf16(o[1][2], o[1][3]);
                *(u32x4*)rowp = w; }
    }
};
struct EpiPlain {
    static constexpr bool PERM = true, AFTER_DRAIN = false;
    bf16_t* O; int ldc;
    __device__ __forceinline__ void operator()(const f32x4 (&acc)[2][2][4][2], const Unit& u, int wr, int wc, int fr, int fq) const {
        const int row0 = u.pm * BM + wr * 64 + fr, col0 = u.pn * BM + wc * 32 + 8 * fq;
#pragma unroll
        for (int ai = 0; ai < 2; ++ai)
#pragma unroll
            for (int m = 0; m < 4; ++m) { bf16_t* rowp = O + (size_t)(row0 + ai * HALF + m * 16) * ldc + col0;
#pragma unroll
                for (int bj = 0; bj < 2; ++bj) { const f32x4 v0 = acc[ai][bj][m][0], v1 = acc[ai][bj][m][1];
                    u32x4 w; w.x = cvt_pk_bf16(v0[0], v0[1]); w.y = cvt_pk_bf16(v0[2], v0[3]); w.z = cvt_pk_bf16(v1[0], v1[1]); w.w = cvt_pk_bf16(v1[2], v1[3]);
                    *(u32x4*)(rowp + bj * HALF) = w; } }
    }
};


struct SplitOrder {
    int nN, S, klen, G, c, pm;
    __device__ __forceinline__ bool next(int i, Unit& u) const { const int L = i * G + c; if (L >= nN * S) return false; u.pm = pm; u.pn = L % nN; u.ks = L / nN; u.koff = u.ks * klen; return true; }
    __device__ __forceinline__ void a_ready(const Unit&) const {}
    __device__ __forceinline__ void done(const Unit&) const {}
};
struct EpiSlab {
    static constexpr bool PERM = false, AFTER_DRAIN = false;
    float* S; int N;
    __device__ __forceinline__ void operator()(const f32x4 (&acc)[2][2][4][2], const Unit& u, int wr, int wc, int fr, int fq) const {
        const int row0 = wr * 64 + fr, col0 = u.pn * BM + wc * 32 + 4 * fq; float* base = S + (size_t)u.ks * 144 * N;
#pragma unroll
        for (int ai = 0; ai < 2; ++ai)
#pragma unroll
            for (int m = 0; m < 4; ++m) { const int r = row0 + ai * HALF + m * 16;
                if (r < 144) { float* rowp = base + (size_t)r * N + col0;
#pragma unroll
                    for (int bj = 0; bj < 2; ++bj)
#pragma unroll
                        for (int n = 0; n < 2; ++n) *(f32x4*)(rowp + bj * HALF + n * 16) = acc[ai][bj][m][n]; } }
    }
};
template <class Epi, class Sched, bool ALIGN_EPI = false, bool SP2 = false>
__device__ __forceinline__ void gemm_phase(PG8_LAS unsigned char* lds, const Gemm g, const Sched& S, const Epi& E) {
    const int tid = threadIdx.x, wid = __builtin_amdgcn_readfirstlane(tid >> 6), lane = tid & 63, wr = wid >> 2, wc = wid & 3, fr = lane & 15, fq = lane >> 4;
    const int K = g.K, nt = K / BK, ld = g.ld;
    unsigned voffA[2], voffB[2];
#pragma unroll
    for (int i = 0; i < 2; ++i) { int R, C; stage_rc(tid * 16 + i * 8192, R, C); const int Rb = Epi::PERM ? ((R & ~31) + perm32(R & 31)) : R;
        voffA[i] = (unsigned)(R * ld + C) * 2u; voffB[i] = (unsigned)(Rb * ld + C) * 2u; }
    const size_t kstep = (size_t)(BK * 2);
    const size_t hstep = (size_t)HALF * ld * 2;
    const size_t tstep = 2 * hstep;
    const unsigned ldsw = (unsigned)wid * 1024u;
    const int aoff = lds_byte(wr * 64 + fr, fq * 8), boff = lds_byte(wc * 32 + fr, fq * 8);
#define PG8_SA(b, h) (((b) * 2 + (h)) * HTB)
#define PG8_SB(b, h) ((4 + (b) * 2 + (h)) * HTB)
#define PG8_STAGE(bufoff, gbase, voff) do { _Pragma("unroll") for (int _i = 0; _i < 2; ++_i) \
        __builtin_amdgcn_global_load_lds((const unsigned*)((const char*)(gbase) + (voff)[_i]), (PG8_LAS unsigned*)(lds + (bufoff) + ldsw + _i * 8192), 16, 0, 0); } while (0)
#define PG8_LDA(dst, b, h) do { _Pragma("unroll") for (int m = 0; m < 4; ++m) _Pragma("unroll") for (int k = 0; k < 2; ++k) dst[m][k] = *(const PG8_LAS bf16x8*)(lds + PG8_SA(b, h) + aoff + m * 2048 + k * 1024); } while (0)
#define PG8_LDB(dst, b, h) do { _Pragma("unroll") for (int n = 0; n < 2; ++n) _Pragma("unroll") for (int k = 0; k < 2; ++k) dst[n][k] = *(const PG8_LAS bf16x8*)(lds + PG8_SB(b, h) + boff + n * 2048 + k * 1024); } while (0)
#define PG8_MMA(ai, bj, At, Bt) do { __builtin_amdgcn_s_setprio(1); _Pragma("unroll") for (int m = 0; m < 4; ++m) _Pragma("unroll") for (int n = 0; n < 2; ++n) _Pragma("unroll") for (int k = 0; k < 2; ++k) \
        acc[ai][bj][m][n] = __builtin_amdgcn_mfma_f32_16x16x32_bf16(Bt[n][k], At[m][k], acc[ai][bj][m][n], 0, 0, 0); __builtin_amdgcn_s_setprio(0); } while (0)
#define PG8_WAIT_V(n) asm volatile("s_waitcnt vmcnt(" #n ")" ::: "memory")
#define PG8_WAIT_L(n) asm volatile("s_waitcnt lgkmcnt(" #n ")" ::: "memory")
#define PG8_BAR __builtin_amdgcn_s_barrier()
#define PG8_SCHED __builtin_amdgcn_sched_barrier(0)
    Unit cur, nxt; int ui = 0;
    if (!S.next(0, cur)) return;
    f32x4 acc[2][2][4][2];
#pragma unroll
    for (int a = 0; a < 2; ++a)
#pragma unroll
        for (int b = 0; b < 2; ++b)
#pragma unroll
            for (int m = 0; m < 4; ++m)
#pragma unroll
                for (int n = 0; n < 2; ++n) acc[a][b][m][n] = (f32x4){0.f, 0.f, 0.f, 0.f};
    bf16x8 At[4][2], B0[2][2], B1[2][2];
    const char* cA = (const char*)g.A + (size_t)cur.pm * tstep + (size_t)cur.koff * 2; const char* cB = (const char*)g.Bt + (size_t)cur.pn * tstep + (size_t)cur.koff * 2;
    S.a_ready(cur);
    if constexpr (SP2) {
        PG8_STAGE(PG8_SB(0, 0), cB, voffB); PG8_STAGE(PG8_SB(0, 1), cB + hstep, voffB); PG8_STAGE(PG8_SA(0, 0), cA, voffA); PG8_STAGE(PG8_SA(0, 1), cA + hstep, voffA);
        if (wr == 1) PG8_BAR;
        PG8_WAIT_V(2); PG8_BAR;
        PG8_STAGE(PG8_SB(1, 0), cB + kstep, voffB); PG8_STAGE(PG8_SA(1, 0), cA + kstep, voffA); PG8_STAGE(PG8_SB(1, 1), cB + hstep + kstep, voffB);
        PG8_WAIT_V(6); PG8_BAR;
    } else {
        PG8_STAGE(PG8_SB(0, 0), cB, voffB); PG8_STAGE(PG8_SA(0, 0), cA, voffA); PG8_STAGE(PG8_SB(0, 1), cB + hstep, voffB); PG8_STAGE(PG8_SA(0, 1), cA + hstep, voffA);
        if (wr == 1) PG8_BAR;
        PG8_WAIT_V(4); PG8_BAR;
        PG8_STAGE(PG8_SB(1, 0), cB + kstep, voffB); PG8_STAGE(PG8_SA(1, 0), cA + kstep, voffA); PG8_STAGE(PG8_SB(1, 1), cB + hstep + kstep, voffB);
        PG8_WAIT_V(6); PG8_BAR;
    }
    for (;;) {
        const bool has_next = S.next(ui + 1, nxt);
        const char* nA = has_next ? (const char*)g.A + (size_t)nxt.pm * tstep + (size_t)nxt.koff * 2 : cA; const char* nB = has_next ? (const char*)g.Bt + (size_t)nxt.pn * tstep + (size_t)nxt.koff * 2 : cB;
        for (int t = 0; t < nt; t += 2) {
            const bool last = (t == nt - 2);
            const char* a1 = cA + (size_t)(t + 1) * kstep;
            const char* a2 = last ? nA : cA + (size_t)(t + 2) * kstep; const char* b2 = last ? nB : cB + (size_t)(t + 2) * kstep;
            const char* a3 = a2 + kstep; const char* b3 = b2 + kstep;
            if (last && has_next) S.a_ready(nxt);
            if constexpr (SP2) {
            PG8_LDB(B0, 0, 0); PG8_LDB(B1, 0, 1); PG8_SCHED; PG8_LDA(At, 0, 0); PG8_STAGE(PG8_SA(1, 1), a1 + hstep, voffA);
            PG8_WAIT_V(8); PG8_WAIT_L(0); PG8_BAR; PG8_MMA(0, 0, At, B0); PG8_MMA(0, 1, At, B1); PG8_BAR; PG8_SCHED;
            PG8_LDA(At, 0, 1); PG8_STAGE(PG8_SB(0, 0), b2, voffB); PG8_STAGE(PG8_SB(0, 1), b2 + hstep, voffB); PG8_STAGE(PG8_SA(0, 0), a2, voffA);
            PG8_WAIT_V(8); PG8_WAIT_L(0); PG8_BAR; PG8_MMA(1, 0, At, B0); PG8_MMA(1, 1, At, B1); PG8_BAR; PG8_SCHED;
            PG8_LDB(B0, 1, 0); PG8_LDB(B1, 1, 1); PG8_SCHED; PG8_LDA(At, 1, 0); PG8_STAGE(PG8_SA(0, 1), a2 + hstep, voffA);
            PG8_WAIT_V(8); PG8_WAIT_L(0); PG8_BAR; PG8_MMA(0, 0, At, B0); PG8_MMA(0, 1, At, B1); PG8_BAR; PG8_SCHED;
            PG8_LDA(At, 1, 1); PG8_STAGE(PG8_SB(1, 0), b3, voffB); PG8_STAGE(PG8_SB(1, 1), b3 + hstep, voffB); PG8_STAGE(PG8_SA(1, 0), a3, voffA);
            PG8_WAIT_V(8); PG8_WAIT_L(0); PG8_BAR; PG8_MMA(1, 0, At, B0); PG8_MMA(1, 1, At, B1); PG8_BAR; PG8_SCHED;
            } else {
            PG8_LDB(B0, 0, 0); PG8_SCHED; PG8_LDA(At, 0, 0); PG8_STAGE(PG8_SA(1, 1), a1 + hstep, voffA);
            PG8_WAIT_L(8); PG8_BAR; PG8_WAIT_L(0); PG8_MMA(0, 0, At, B0); PG8_BAR; PG8_SCHED;
            PG8_LDB(B1, 0, 1); PG8_STAGE(PG8_SB(0, 0), b2, voffB);
            PG8_BAR; PG8_WAIT_L(0); PG8_MMA(0, 1, At, B1); PG8_BAR;
            PG8_LDA(At, 0, 1); PG8_STAGE(PG8_SA(0, 0), a2, voffA);
            PG8_BAR; PG8_WAIT_L(0); PG8_MMA(1, 0, At, B0); PG8_BAR; PG8_SCHED;
            PG8_STAGE(PG8_SB(0, 1), b2 + hstep, voffB);
            PG8_WAIT_V(6); PG8_BAR; PG8_MMA(1, 1, At, B1); PG8_BAR;
            PG8_LDB(B0, 1, 0); PG8_SCHED; PG8_LDA(At, 1, 0); PG8_STAGE(PG8_SA(0, 1), a2 + hstep, voffA);
            PG8_WAIT_L(8); PG8_BAR; PG8_WAIT_L(0); PG8_MMA(0, 0, At, B0); PG8_BAR; PG8_SCHED;
            PG8_LDB(B1, 1, 1); PG8_STAGE(PG8_SB(1, 0), b3, voffB);
            PG8_BAR; PG8_WAIT_L(0); PG8_MMA(0, 1, At, B1); PG8_BAR;
            PG8_LDA(At, 1, 1); PG8_STAGE(PG8_SA(1, 0), a3, voffA);
            PG8_BAR; PG8_WAIT_L(0); PG8_MMA(1, 0, At, B0); PG8_BAR; PG8_SCHED;
            PG8_STAGE(PG8_SB(1, 1), b3 + hstep, voffB);
            PG8_WAIT_V(6); PG8_BAR; PG8_MMA(1, 1, At, B1); PG8_BAR;
            }
        }
        if constexpr (ALIGN_EPI) { if (wr == 0) PG8_BAR; }
        if constexpr (!Epi::AFTER_DRAIN) { E(acc, cur, wr, wc, fr, fq); S.done(cur); }
        if (!has_next) break;
#pragma unroll
        for (int a = 0; a < 2; ++a)
#pragma unroll
            for (int b = 0; b < 2; ++b)
#pragma unroll
                for (int m = 0; m < 4; ++m)
#pragma unroll
                    for (int n = 0; n < 2; ++n) acc[a][b][m][n] = (f32x4){0.f, 0.f, 0.f, 0.f};
        cur = nxt; cA = nA; cB = nB; ++ui;
        if constexpr (ALIGN_EPI) { if (wr == 1) PG8_BAR; }
    }
    PG8_WAIT_V(0);
    if constexpr (!ALIGN_EPI) { if (wr == 0) PG8_BAR; }
    PG8_BAR;
    if constexpr (Epi::AFTER_DRAIN) { E.fused(acc, cur, wr, wc, fr, fq, lds, wid, lane); S.done(cur); }
#undef PG8_SA
#undef PG8_SB
#undef PG8_STAGE
#undef PG8_LDA
#undef PG8_LDB
#undef PG8_MMA
#undef PG8_WAIT_V
#undef PG8_WAIT_L
#undef PG8_BAR
#undef PG8_SCHED
}
}

#ifndef PG8_SP2
#define PG8_SP2 true
#endif
#ifndef PG8_ALIGN
#define PG8_ALIGN true
#endif

constexpr int NWAVES = 8;
constexpr int D = 1024, DR = 1408, DFF = 2816, NBATCH = 8, SEQ = 2048, NMETA = 16, NSMP = 128;
constexpr int LRU_BW = 88;
constexpr int MROWS = 16640;
constexpr int R_META = 16384, R_SMP = 16400, R_END = 16528;
constexpr int S5_RB = 1160;
constexpr float RMS_EPS = 1e-6f;
constexpr size_t O_YP = 0, O_YS = 16777216, O_LHP = 16908288, O_LCP = 16919552, O_SRP = 16953344, O_SIP = 16986112,
                 O_LHS = 17018880, O_LCS = 17199104, O_SRS = 17739776, O_SIS = 18264064, O_END = 18788352;
constexpr size_t al256(size_t x) { return (x + 255) & ~(size_t)255; }
constexpr size_t WS_CTL = 0, CTL_ZERO_BYTES = 1u << 20;
constexpr size_t WS_W1T = CTL_ZERO_BYTES;
constexpr size_t WS_W2T = WS_W1T + (size_t)2816 * 1024 * 2;
constexpr size_t WS_W3T = WS_W2T + (size_t)1024 * 1408 * 2;
constexpr size_t WS_W4T = WS_W3T + (size_t)2 * 5632 * 1024 * 2;
constexpr size_t WS_W5T = WS_W4T + (size_t)2 * 1024 * 2816 * 2;
constexpr size_t WS_WGT = WS_W5T + (size_t)2048 * 1024 * 2;
constexpr size_t WS_S5WE = WS_WGT + (size_t)16 * 2 * 96 * 96 * 2;
constexpr size_t WS_S5WY = WS_S5WE + (size_t)64 * 128 * 256 * 2;
constexpr size_t WS_S5C = WS_S5WY + (size_t)64 * 256 * 384 * 2;
constexpr size_t WS_XEX = WS_S5C + (size_t)6 * 4096 * 4;
constexpr size_t WS_XN = WS_XEX + (size_t)256 * 1024 * 4;
constexpr size_t WS_R1 = WS_XN + (size_t)MROWS * 1024 * 2;
constexpr size_t WS_R2 = WS_R1 + (size_t)MROWS * 2816 * 2;
constexpr size_t WS_SLAB = WS_R2 + (size_t)MROWS * 1408 * 2;
constexpr size_t WS_END = WS_SLAB + (size_t)11 * 144 * 1024 * 4;
static_assert(WS_END <= (size_t)268435456, "d_ws map exceeds 256 MiB");
static_assert((WS_W1T % 256) == 0 && (WS_W2T % 256) == 0 && (WS_W3T % 256) == 0 && (WS_W4T % 256) == 0 && (WS_W5T % 256) == 0 && (WS_WGT % 256) == 0 && (WS_S5WE % 256) == 0 &&
              (WS_S5WY % 256) == 0 && (WS_S5C % 256) == 0 && (WS_XEX % 256) == 0 && (WS_XN % 256) == 0 && (WS_R1 % 256) == 0 && (WS_R2 % 256) == 0, "alignment");
constexpr int CW_BAR = 4096;
constexpr int RING_OFF = 0, RING_BYTES = 131072;
constexpr int LDSCTL_OFF = RING_BYTES, MISC_OFF = LDSCTL_OFF + 320;
constexpr int LDS_BYTES = 147456;

#define GAS __attribute__((address_space(1)))
#define LAS __attribute__((address_space(3)))
typedef unsigned short bf16;
typedef unsigned v4u __attribute__((ext_vector_type(4)));
typedef unsigned v2u __attribute__((ext_vector_type(2)));
typedef float f32x4 __attribute__((ext_vector_type(4)));
typedef short bf16x8 __attribute__((ext_vector_type(8)));
typedef GAS unsigned gu32;
#define LDS_WAIT() asm volatile("s_waitcnt lgkmcnt(0)" ::: "memory")
#define VM_WAIT() asm volatile("s_waitcnt vmcnt(0)" ::: "memory")
__device__ __forceinline__ unsigned f2bf(float f) { unsigned u = __builtin_bit_cast(unsigned, f); return (u + 0x7fffu + ((u >> 16) & 1u)) >> 16; }
__device__ __forceinline__ unsigned pk2(float lo, float hi) { return f2bf(lo) | (f2bf(hi) << 16); }
__device__ __forceinline__ float bf2f(unsigned short b) { return __builtin_bit_cast(float, (unsigned)b << 16); }
__device__ __forceinline__ float bflo(unsigned w) { return __builtin_bit_cast(float, w << 16); }
__device__ __forceinline__ float bfhi(unsigned w) { return __builtin_bit_cast(float, w & 0xffff0000u); }
__device__ __forceinline__ float wave_sum(float v) {
#pragma unroll
    for (int o = 1; o < 64; o <<= 1) v += __shfl_xor(v, o);
    return v;
}
using pg8::gelu_tanh_f; using pg8::sigmoid_f;

#define XB_TMO      128
#define XB_XCNT(j)  (256  + 64 * (j))
#define XB_XSUB(j)  (1280 + 64 * (j))
#define XB_XGEN(j)  (2304 + 64 * (j))
#define XB_TOP      3328
#define XB_TOPGEN   3392
#define XCD_BAR_WORDS 3456
#define XB_SPIN_CAP (1u << 18)

__device__ __forceinline__ unsigned xb_ld(unsigned* p)              { return __hip_atomic_load(p, __ATOMIC_RELAXED, __HIP_MEMORY_SCOPE_AGENT); }
__device__ __forceinline__ unsigned xb_add(unsigned* p, unsigned v) { return __hip_atomic_fetch_add(p, v, __ATOMIC_RELAXED, __HIP_MEMORY_SCOPE_AGENT); }
__device__ __forceinline__ unsigned xb_xcc_id() { return (unsigned)__builtin_amdgcn_s_getreg((3 << 11) | 20) & 0xFu; }
#define XB_SPIN(cond, bar) do { unsigned _sp = 0; while (cond) { __builtin_amdgcn_s_sleep(1); \
    if ((++_sp & 255u) == 0u) { if (xb_ld(&(bar)[XB_TMO])) break; if (_sp > XB_SPIN_CAP) { atomicAdd(&(bar)[XB_TMO], 1u); break; } } } } while (0)

struct XcdBarrier {
    unsigned* bar; unsigned x;
    volatile LAS unsigned* st;
};

__device__ __forceinline__ XcdBarrier xcd_barrier_post(unsigned* bar, volatile LAS unsigned* st) {
    XcdBarrier b; b.bar = bar; b.x = xb_xcc_id(); b.st = st;
    if (threadIdx.x == 0) (void)xb_add(&bar[XB_XCNT(b.x)], 1u);
    return b;
}
__device__ __forceinline__ void xcd_barrier_complete(unsigned* bar, unsigned x, unsigned& nloc, unsigned& nx) {
    const unsigned G = gridDim.x * gridDim.y * gridDim.z;
    unsigned sum, cnt, mine, sp = 0u;
    for (;;) {
        sum = 0u; cnt = 0u; mine = 0u;
#pragma unroll
        for (unsigned j = 0; j < 16; ++j) { const unsigned c = xb_ld(&bar[XB_XCNT(j)]); sum += c; cnt += (c > 0u) ? 1u : 0u; mine = (j == x) ? c : mine; }
        if (sum == G) break;
        __builtin_amdgcn_s_sleep(1);
        if ((++sp & 255u) == 0u) { if (xb_ld(&bar[XB_TMO])) break; if (sp > XB_SPIN_CAP) { atomicAdd(&bar[XB_TMO], 1u); break; } }
    }
    nloc = mine > 0u ? mine : 1u; nx = cnt > 0u ? cnt : 1u;
}

__device__ __forceinline__ void xcd_barrier(const XcdBarrier& b) {
    asm volatile("s_waitcnt vmcnt(0)" ::: "memory");
    __syncthreads();
    if (threadIdx.x == 0) {
        unsigned* bar = b.bar;
        __builtin_amdgcn_s_waitcnt(0);
        unsigned nloc = b.st[0], nx = b.st[1];
        if (nloc == 0u) { xcd_barrier_complete(bar, b.x, nloc, nx); b.st[0] = nloc; b.st[1] = nx; }
        const unsigned old = xb_add(&bar[XB_XSUB(b.x)], 1u);
        const unsigned gen = old / nloc;
        if (old + 1u == (gen + 1u) * nloc) {
            __builtin_amdgcn_fence(__ATOMIC_RELEASE, "agent");
            asm volatile("s_waitcnt vmcnt(0)" ::: "memory");
            const unsigned og = xb_add(&bar[XB_TOP], 1u);
            const unsigned tg = og / nx;
            if (og + 1u == (tg + 1u) * nx) xb_add(&bar[XB_TOPGEN], 1u);
            else XB_SPIN(xb_ld(&bar[XB_TOPGEN]) == tg, bar);
            __builtin_amdgcn_fence(__ATOMIC_ACQUIRE, "agent");
            xb_add(&bar[XB_XGEN(b.x)], 1u);
            asm volatile("s_waitcnt vmcnt(0)" ::: "memory");
        } else {
            XB_SPIN(xb_ld(&bar[XB_XGEN(b.x)]) == gen, bar);
            __builtin_amdgcn_fence(__ATOMIC_ACQUIRE, "agent");
            asm volatile("s_waitcnt vmcnt(0)" ::: "memory");
        }
    }
    __syncthreads();
}

struct Args { const float* in[28]; float* out; unsigned char* ws; int ph_lo, ph_hi; };
enum { I_XP = 0, I_XS, I_LH, I_LC, I_SRE, I_SIM, I_META, I_GAIN, I_LWIN, I_LWCONV, I_LBCONV, I_LWA, I_LBA, I_LWX, I_LBX, I_LLAM, I_LWOUT,
       I_SLRE, I_SLIM, I_SLDT, I_SBRE, I_SBIM, I_SCRE, I_SCIM, I_SD, I_SWOUT, I_FWIN, I_FWOUT };

struct Ctx {
    LAS unsigned char* lds;
    int tid, lane, wave, vcu, G;
    const float* const* in; float* out; unsigned char* ws;
};

__device__ __forceinline__ void transpose_item(const float* W, int K, int N, bf16* WT, int half, LAS float* scr, int item, int lane) {
    const int nblk = N / 32, kb = item / nblk, nb = item % nblk, k0 = 64 * kb, n0 = 32 * nb;
    int r0 = n0;
    if (half) { const int c = n0 < half ? n0 : n0 - half; r0 = 256 * (c >> 7) + (c & 127) + (n0 < half ? 0 : 128); }
#pragma unroll 8
    for (int i = 0; i < 32; ++i) { const int kk = 2 * i + (lane >> 5); scr[kk * 33 + (lane & 31)] = W[(size_t)(k0 + kk) * N + n0 + (lane & 31)]; }
    LDS_WAIT(); asm volatile("" ::: "memory");
    const int c = lane & 7;
#pragma unroll
    for (int j = 0; j < 4; ++j) { const int n = (lane >> 3) + 8 * j; const LAS float* s = scr + (8 * c) * 33 + n;
        v4u o; o.x = pk2(s[0 * 33], s[1 * 33]); o.y = pk2(s[2 * 33], s[3 * 33]); o.z = pk2(s[4 * 33], s[5 * 33]); o.w = pk2(s[6 * 33], s[7 * 33]);
        *(GAS v4u*)(WT + (size_t)(r0 + n) * K + k0 + 8 * c) = o; }
    LDS_WAIT(); asm volatile("" ::: "memory");
}
__device__ __forceinline__ const float* x0_row(const Ctx& C, int r) {
    if (r < R_META) return C.in[I_XP] + (size_t)r * D;
    if (r < R_SMP) return C.in[I_META] + (size_t)(r - R_META) * D;
    return C.in[I_XS] + (size_t)(r - R_SMP) * D;
}
__device__ __forceinline__ float* xs_row(const Ctx& C, int r) {
    if (r < R_META) return C.out + O_YP + (size_t)r * D;
    return (float*)(C.ws + WS_XEX) + (size_t)(r - R_META) * D;
}
__device__ __forceinline__ float sin2pi(float turns) { return __builtin_amdgcn_sinf(turns - rintf(turns)); }
__device__ __forceinline__ float cos2pi(float turns) { return __builtin_amdgcn_cosf(turns - rintf(turns)); }

__device__ __forceinline__ void s5_prep_group(const Ctx& C, int g) {
    LAS float* PWr = (LAS float*)(C.lds + RING_OFF);
    LAS float* PWi = PWr + 17 * 64;
    LAS float* BBr = PWi + 17 * 64;
    LAS float* BBi = BBr + 1024;
    LAS float* Cr = BBi + 1024;
    LAS float* Ci = Cr + 1024;
    LAS float* KT = Ci + 1024;
    const int tid = C.tid;
    const float INV2PI = 0.15915494309189535f;
    if (tid < 64) {
        const int p = tid;
        const float dt = expf(C.in[I_SLDT][g]);
        const float lr = C.in[I_SLRE][g * 64 + p], li = C.in[I_SLIM][g * 64 + p];
        const float x = dt * lr, y = dt * li, yt = y * INV2PI;
        for (int tau = 0; tau <= 16; ++tau) { const float mag = expf((float)tau * x), tr = (float)tau * yt;
            PWr[tau * 64 + p] = mag * cos2pi(tr); PWi[tau * 64 + p] = mag * sin2pi(tr); }
        const float em1 = expm1f(x), cy = cos2pi(yt), sy = sin2pi(yt), sh = sin2pi(0.5f * yt), cm1 = -2.0f * sh * sh;
        const float ar = em1 * cy + cm1, ai = (em1 + 1.0f) * sy;
        const float den = 1.0f / (lr * lr + li * li);
        const float qr = (ar * lr + ai * li) * den, qi = (ai * lr - ar * li) * den;
        for (int c = 0; c < 16; ++c) { const float br = C.in[I_SBRE][(size_t)(g * 64 + p) * 16 + c], bi = C.in[I_SBIM][(size_t)(g * 64 + p) * 16 + c];
            BBr[p * 16 + c] = qr * br - qi * bi; BBi[p * 16 + c] = qr * bi + qi * br; }
        float* S5C = (float*)(C.ws + WS_S5C);
        S5C[0 * 4096 + g * 64 + p] = PWr[16 * 64 + p]; S5C[1 * 4096 + g * 64 + p] = PWi[16 * 64 + p];
        S5C[2 * 4096 + g * 64 + p] = PWr[1 * 64 + p];  S5C[3 * 4096 + g * 64 + p] = PWi[1 * 64 + p];
        const float mag = expf(-15.0f * x), tr = -15.0f * yt;
        S5C[4 * 4096 + g * 64 + p] = mag * cos2pi(tr); S5C[5 * 4096 + g * 64 + p] = mag * sin2pi(tr);
    }
    for (int i = tid; i < 1024; i += 512) { Cr[i] = C.in[I_SCRE][(size_t)g * 1024 + i]; Ci[i] = C.in[I_SCIM][(size_t)g * 1024 + i]; }
    __syncthreads();
    for (int e = tid; e < 4096; e += 512) { const int tau = e >> 8, co = (e >> 4) & 15, ci = e & 15; float acc = 0.f;
        for (int p = 0; p < 64; ++p) { const float pr = PWr[tau * 64 + p], pi = PWi[tau * 64 + p], br = BBr[p * 16 + ci], bi = BBi[p * 16 + ci];
            const float tr = pr * br - pi * bi, ti = pr * bi + pi * br; acc += Cr[co * 64 + p] * tr - Ci[co * 64 + p] * ti; }
        KT[e] = acc; }
    __syncthreads();
    bf16* WY = (bf16*)(C.ws + WS_S5WY) + (size_t)g * 256 * 384;
    for (int e = tid; e < 256 * 48; e += 512) { const int n = e / 48, kg = e % 48, t = n >> 4, co = n & 15; float v[8];
#pragma unroll
        for (int q = 0; q < 8; ++q) { const int k = kg * 8 + q; float val;
            if (k < 256) { const int s = k >> 4, ci = k & 15; val = (s <= t) ? KT[(t - s) * 256 + co * 16 + ci] : 0.f; }
            else if (k < 320) { const int p = k - 256; val = Cr[co * 64 + p] * PWr[(t + 1) * 64 + p] - Ci[co * 64 + p] * PWi[(t + 1) * 64 + p]; }
            else { const int p = k - 320; val = -(Cr[co * 64 + p] * PWi[(t + 1) * 64 + p] + Ci[co * 64 + p] * PWr[(t + 1) * 64 + p]); }
            v[q] = val; }
        v4u o; o.x = pk2(v[0], v[1]); o.y = pk2(v[2], v[3]); o.z = pk2(v[4], v[5]); o.w = pk2(v[6], v[7]);
        *(GAS v4u*)(WY + (size_t)n * 384 + kg * 8) = o; }
    bf16* WE = (bf16*)(C.ws + WS_S5WE) + (size_t)g * 128 * 256;
    for (int e = tid; e < 128 * 32; e += 512) { const int n = e >> 5, kg = e & 31, p = n & 63, im = n >> 6; float v[8];
#pragma unroll
        for (int q = 0; q < 8; ++q) { const int k = kg * 8 + q, s = k >> 4, ci = k & 15;
            const float pr = PWr[(15 - s) * 64 + p], pi = PWi[(15 - s) * 64 + p], br = BBr[p * 16 + ci], bi = BBi[p * 16 + ci];
            v[q] = im ? (pr * bi + pi * br) : (pr * br - pi * bi); }
        v4u o; o.x = pk2(v[0], v[1]); o.y = pk2(v[2], v[3]); o.z = pk2(v[4], v[5]); o.w = pk2(v[6], v[7]);
        *(GAS v4u*)(WE + (size_t)n * 256 + kg * 8) = o; }
    __syncthreads();
}

__device__ __forceinline__ void p0_prologue(const Ctx& C) {
    __syncthreads();
    if (C.vcu < 64) s5_prep_group(C, C.vcu);
    LAS float* scr = (LAS float*)(C.lds + RING_OFF + C.wave * 16384);
    const int gw = C.vcu * NWAVES + C.wave, NGW = C.G * NWAVES;
    constexpr int I_1 = (1024 / 64) * (2816 / 32), I_2 = (1408 / 64) * (1024 / 32), I_3 = (1024 / 64) * (5632 / 32), I_4 = (2816 / 64) * (1024 / 32), I_5 = (1024 / 64) * (2048 / 32);
    constexpr int NITEMS = I_1 + I_2 + 2 * I_3 + 2 * I_4 + I_5;
    for (int it = gw; it < NITEMS; it += NGW) {
        int r = it;
        if (r < I_1) { transpose_item(C.in[I_LWIN], 1024, 2816, (bf16*)(C.ws + WS_W1T), 0, scr, r, C.lane); continue; } r -= I_1;
        if (r < I_2) { transpose_item(C.in[I_LWOUT], 1408, 1024, (bf16*)(C.ws + WS_W2T), 0, scr, r, C.lane); continue; } r -= I_2;
        if (r < I_3) { transpose_item(C.in[I_FWIN], 1024, 5632, (bf16*)(C.ws + WS_W3T), 2816, scr, r, C.lane); continue; } r -= I_3;
        if (r < I_3) { transpose_item(C.in[I_FWIN] + (size_t)1024 * 5632, 1024, 5632, (bf16*)(C.ws + WS_W3T) + (size_t)5632 * 1024, 2816, scr, r, C.lane); continue; } r -= I_3;
        if (r < I_4) { transpose_item(C.in[I_FWOUT], 2816, 1024, (bf16*)(C.ws + WS_W4T), 0, scr, r, C.lane); continue; } r -= I_4;
        if (r < I_4) { transpose_item(C.in[I_FWOUT] + (size_t)2816 * 1024, 2816, 1024, (bf16*)(C.ws + WS_W4T) + (size_t)1024 * 2816, 0, scr, r, C.lane); continue; } r -= I_4;
        transpose_item(C.in[I_SWOUT], 1024, 2048, (bf16*)(C.ws + WS_W5T), 1024, scr, r, C.lane);
    }
    { bf16* WG = (bf16*)(C.ws + WS_WGT); const int gt = (C.vcu * NWAVES + C.wave) * 64 + C.lane, NT = C.G * 512;
      for (int e = gt; e < 16 * 2 * 96 * 96; e += NT) { const int i = e % 96, j = (e / 96) % 96, gate = (e / 9216) & 1, h = e / 18432;
          const float* wsel = gate ? C.in[I_LWX] : C.in[I_LWA]; float v = 0.f; if (i < 88 && j < 88) v = wsel[(size_t)(h * 88 + i) * 88 + j];
          WG[e] = (bf16)f2bf(v); } }
    { const float* gain = C.in[I_GAIN]; bf16* XN = (bf16*)(C.ws + WS_XN);
      for (int r = gw; r < R_END; r += NGW) {
          const GAS f32x4* xr = (const GAS f32x4*)x0_row(C, r) + C.lane; f32x4 v[4]; float s = 0.f;
#pragma unroll
          for (int j = 0; j < 4; ++j) { v[j] = xr[64 * j]; s += (v[j].x * v[j].x + v[j].y * v[j].y) + (v[j].z * v[j].z + v[j].w * v[j].w); }
          const float rs = rsqrtf(wave_sum(s) * (1.f / D) + RMS_EPS);
          GAS v2u* o8 = (GAS v2u*)(XN + (size_t)r * D) + C.lane;
#pragma unroll
          for (int j = 0; j < 4; ++j) { const f32x4 gg = *((const GAS f32x4*)gain + C.lane + 64 * j);
              v2u o; o.x = pk2(v[j].x * rs * gg.x, v[j].y * rs * gg.y); o.y = pk2(v[j].z * rs * gg.z, v[j].w * rs * gg.w); o8[64 * j] = o; } } }
}

template <int MODE>
__device__ __forceinline__ void nr_phase(const Ctx& C, const bf16* MB, const float* ga, const float* gb, int nslab, int ldn, bool glu) {
    const float* slab = (const float*)(C.ws + WS_SLAB);
    const int gw = C.vcu * NWAVES + C.wave, NGW = C.G * NWAVES, lane = C.lane;
    bf16* XN = (bf16*)(C.ws + WS_XN); bf16* XNS = (bf16*)(C.ws + WS_R1);
    for (int r = gw; r < R_END; r += NGW) {
        if (MODE == 3 && r >= R_META && r < R_SMP) continue;
        const float* xsrc = (MODE == 0) ? x0_row(C, r) : xs_row(C, r);
        float* xdst = (MODE == 3 && r >= R_SMP) ? C.out + O_YS + (size_t)(r - R_SMP) * D : xs_row(C, r);
        const GAS v2u* mr = (const GAS v2u*)(MB + (size_t)r * D) + lane;
        f32x4 m[4], x[4]; float s = 0.f;
#pragma unroll
        for (int j = 0; j < 4; ++j) {
            if (r < R_META) { const v2u w = mr[64 * j]; m[j] = (f32x4){bflo(w.x), bfhi(w.x), bflo(w.y), bfhi(w.y)}; }
            else {
                const int er = r - R_META; f32x4 a0 = {0.f, 0.f, 0.f, 0.f}, a1 = {0.f, 0.f, 0.f, 0.f};
                const int cz = glu ? 256 * (2 * j + (lane >> 5)) + 4 * (lane & 31) : 256 * j + 4 * lane;
                for (int sidx = 0; sidx < nslab; ++sidx) { const float* sp = slab + ((size_t)sidx * 144 + er) * ldn + cz;
                    a0 = a0 + *(const GAS f32x4*)sp; if (glu) a1 = a1 + *(const GAS f32x4*)(sp + 128); }
                if (glu) { a0.x *= sigmoid_f(a1.x); a0.y *= sigmoid_f(a1.y); a0.z *= sigmoid_f(a1.z); a0.w *= sigmoid_f(a1.w); }
                m[j] = a0; }
            x[j] = *((const GAS f32x4*)xsrc + lane + 64 * j);
            s += (m[j].x * m[j].x + m[j].y * m[j].y) + (m[j].z * m[j].z + m[j].w * m[j].w); }
        const float rs = rsqrtf(wave_sum(s) * (1.f / D) + RMS_EPS);
        float s2 = 0.f;
#pragma unroll
        for (int j = 0; j < 4; ++j) { const f32x4 gg = *((const GAS f32x4*)ga + lane + 64 * j);
            x[j] = x[j] + m[j] * rs * gg; s2 += (x[j].x * x[j].x + x[j].y * x[j].y) + (x[j].z * x[j].z + x[j].w * x[j].w);
            *((GAS f32x4*)xdst + lane + 64 * j) = x[j]; }
        if (MODE == 3) continue;
        const float rs2 = rsqrtf(wave_sum(s2) * (1.f / D) + RMS_EPS);
        v2u o[4];
#pragma unroll
        for (int j = 0; j < 4; ++j) { const f32x4 gg = *((const GAS f32x4*)gb + lane + 64 * j);
            o[j].x = pk2(x[j].x * rs2 * gg.x, x[j].y * rs2 * gg.y); o[j].y = pk2(x[j].z * rs2 * gg.z, x[j].w * rs2 * gg.w); }
        if (MODE == 1) {
            if (r < R_META) { const int b = r >> 11, jt = r & 2047, rb = b * 129 + 1 + (jt >> 4), s = jt & 15;
#pragma unroll
                for (int j = 0; j < 4; ++j) *(GAS v2u*)(XNS + (((size_t)rb * 64 + 16 * j + (lane >> 2)) * 16 + s) * 16 + 4 * (lane & 3)) = o[j]; }
            else if (r < R_SMP) { const int s = r - R_META;
                for (int b = 0; b < NBATCH; ++b)
#pragma unroll
                    for (int j = 0; j < 4; ++j) *(GAS v2u*)(XNS + (((size_t)(b * 129) * 64 + 16 * j + (lane >> 2)) * 16 + s) * 16 + 4 * (lane & 3)) = o[j]; }
            else { const int rb = 1032 + (r - R_SMP);
#pragma unroll
                for (int j = 0; j < 4; ++j) *(GAS v2u*)(XNS + (((size_t)rb * 64 + 16 * j + (lane >> 2)) * 16 + 0) * 16 + 4 * (lane & 3)) = o[j];
                GAS v2u* zb = (GAS v2u*)(XNS + (size_t)rb * 64 * 256);
                for (int e = lane; e < 64 * 60; e += 64) { const int g = e / 60, q = e % 60; zb[g * 64 + 4 + q] = (v2u){0u, 0u}; } }
        } else {
            GAS v2u* o8 = (GAS v2u*)(XN + (size_t)r * D) + lane;
#pragma unroll
            for (int j = 0; j < 4; ++j) o8[64 * j] = o[j];
        }
    }
}

constexpr int L2_XB = 0, L2_XCA = 23552, L2_XCF = 50176, L2_AGG = 101376, L2_CW = 107520;
typedef float f32x2 __attribute__((ext_vector_type(2)));

__device__ __forceinline__ void lru2_block(const Ctx& C) {
    const int b = C.vcu >> 5, h = (C.vcu >> 1) & 15, half = C.vcu & 1;
    const int tid = C.tid, lane = C.lane, w = C.wave, fr = lane & 15, fq = lane >> 4, ch0 = 88 * h;
    LAS bf16* XB = (LAS bf16*)(C.lds + RING_OFF + L2_XB); LAS bf16* XCA = (LAS bf16*)(C.lds + RING_OFF + L2_XCA); LAS float* XCF = (LAS float*)(C.lds + RING_OFF + L2_XCF);
    LAS f32x2* AGG = (LAS f32x2*)(C.lds + RING_OFF + L2_AGG); LAS float* CW = (LAS float*)(C.lds + RING_OFF + L2_CW);
    const bf16* XG = (const bf16*)(C.ws + WS_R1); bf16* A2 = (bf16*)(C.ws + WS_R2);
    float ba[3], bx[3], c1[3]; int chg[3], cll[3]; bool valid[3]; bf16x8 bA[3][3], bX[3][3];
    { const bf16* WG = (const bf16*)(C.ws + WS_WGT);
#pragma unroll
      for (int nt = 0; nt < 3; ++nt) { const int cl = 48 * half + 16 * nt + fr; valid[nt] = cl < 88; cll[nt] = cl < 88 ? cl : 87; chg[nt] = ch0 + cll[nt];
          ba[nt] = C.in[I_LBA][chg[nt]]; bx[nt] = C.in[I_LBX][chg[nt]]; c1[nt] = -8.0f * 1.442695041f * log1pf(expf(-C.in[I_LLAM][chg[nt]]));
#pragma unroll
          for (int ks = 0; ks < 3; ++ks) { bA[nt][ks] = *(const GAS bf16x8*)(WG + ((size_t)(h * 2 + 0) * 96 + cl) * 96 + ks * 32 + fq * 8);
              bX[nt][ks] = *(const GAS bf16x8*)(WG + ((size_t)(h * 2 + 1) * 96 + cl) * 96 + ks * 32 + fq * 8); } } }
    __syncthreads();
    for (int e = tid; e < 5 * 96; e += 512) { const int k = e / 96, i = e % 96; float v = 0.f;
        if (i < 88) v = (k < 4) ? C.in[I_LWCONV][k * DR + ch0 + i] : C.in[I_LBCONV][ch0 + i];
        CW[e] = v; }
    for (int e = tid; e < 128 * 16; e += 512) XCA[(e >> 4) * 104 + 88 + (e & 15)] = 0;
#define LRU_ROW(t) (((t) < NMETA) ? (size_t)(R_META + (t)) : (size_t)b * SEQ + (size_t)((t) - NMETA))
#define LRU_LOAD(c, pf) do { _Pragma("unroll") for (int q = 0; q < 3; ++q) { const int e = tid + 512 * q; (pf)[q] = (v4u){0u, 0u, 0u, 0u}; \
        if (e < 131 * 11) { const int rr = e / 11, pc = e % 11, t = 128 * (c) - 3 + rr; if (t >= 0 && t < NMETA + SEQ) (pf)[q] = *(const GAS v4u*)(XG + LRU_ROW(t) * 2816 + ch0 + pc * 8); } } } while (0)
#define LRU_PUT(pf) do { _Pragma("unroll") for (int q = 0; q < 3; ++q) { const int e = tid + 512 * q; if (e < 131 * 11) { const int rr = e / 11, pc = e % 11; *(LAS v4u*)(XB + rr * 88 + pc * 8) = (pf)[q]; } } } while (0)
    { v4u pf[3]; LRU_LOAD(0, pf); LRU_PUT(pf); }
    __syncthreads();
    float hc[3] = {0.f, 0.f, 0.f};
    for (int c = 0; c < 17; ++c) {
        const int nvw = (c < 16) ? 8 : 1;
        v4u pf[3];
        if (c < 16) LRU_LOAD(c + 1, pf);
#pragma unroll
        for (int q = 0; q < 3; ++q) { const int e = tid + 512 * q;
            if (e < 11 * 128) { const int pc = e >> 7, tl = e & 127; float acc[8];
                { const f32x4 b0 = *(const LAS f32x4*)(CW + 4 * 96 + pc * 8), b1 = *(const LAS f32x4*)(CW + 4 * 96 + pc * 8 + 4);
                  acc[0] = b0.x; acc[1] = b0.y; acc[2] = b0.z; acc[3] = b0.w; acc[4] = b1.x; acc[5] = b1.y; acc[6] = b1.z; acc[7] = b1.w; }
#pragma unroll
                for (int k = 0; k < 4; ++k) { const v4u xv = *(const LAS v4u*)(XB + (tl + k) * 88 + pc * 8);
                    const f32x4 w0 = *(const LAS f32x4*)(CW + k * 96 + pc * 8), w1 = *(const LAS f32x4*)(CW + k * 96 + pc * 8 + 4);
                    acc[0] += w0.x * bflo(xv.x); acc[1] += w0.y * bfhi(xv.x); acc[2] += w0.z * bflo(xv.y); acc[3] += w0.w * bfhi(xv.y);
                    acc[4] += w1.x * bflo(xv.z); acc[5] += w1.y * bfhi(xv.z); acc[6] += w1.z * bflo(xv.w); acc[7] += w1.w * bfhi(xv.w); }
                v4u o; o.x = pk2(acc[0], acc[1]); o.y = pk2(acc[2], acc[3]); o.z = pk2(acc[4], acc[5]); o.w = pk2(acc[6], acc[7]);
                *(LAS v4u*)(XCA + tl * 104 + pc * 8) = o;
                *(LAS f32x4*)(XCF + tl * 100 + pc * 8) = (f32x4){acc[0], acc[1], acc[2], acc[3]}; *(LAS f32x4*)(XCF + tl * 100 + pc * 8 + 4) = (f32x4){acc[4], acc[5], acc[6], acc[7]}; } }
        __syncthreads();
        float A_[3][4], B_[3][4], cA[3], cB[3], gg[3][4];
        {
            bf16x8 a[3];
#pragma unroll
            for (int ks = 0; ks < 3; ++ks) a[ks] = *(const LAS bf16x8*)(XCA + (16 * w + fr) * 104 + ks * 32 + fq * 8);
#pragma unroll
            for (int nt = 0; nt < 3; ++nt) {
                if (w < nvw) {
#pragma unroll
                    for (int j = 0; j < 4; ++j) { const int t = 128 * c + 16 * w + 4 * fq + j; gg[nt][j] = bf2f(XG[LRU_ROW(t) * 2816 + DR + chg[nt]]); } }
                f32x4 accR = {0.f, 0.f, 0.f, 0.f}, accI = {0.f, 0.f, 0.f, 0.f};
#pragma unroll
                for (int ks = 0; ks < 3; ++ks) { accR = __builtin_amdgcn_mfma_f32_16x16x32_bf16(a[ks], bA[nt][ks], accR, 0, 0, 0);
                    accI = __builtin_amdgcn_mfma_f32_16x16x32_bf16(a[ks], bX[nt][ks], accI, 0, 0, 0); }
                float av[4], bv[4];
#pragma unroll
                for (int j = 0; j < 4; ++j) { const float xc = XCF[(16 * w + 4 * fq + j) * 100 + cll[nt]];
                    const float r = sigmoid_f(accR[j] + ba[nt]), ig = sigmoid_f(accI[j] + bx[nt]);
                    const float aa = __builtin_amdgcn_exp2f(c1[nt] * r);
                    const float om = __builtin_fmaf(-aa, aa, 1.0f);
                    av[j] = aa; bv[j] = __builtin_amdgcn_sqrtf(om > 0.f ? om : 0.f) * (ig * xc); }
                A_[nt][0] = av[0]; B_[nt][0] = bv[0];
#pragma unroll
                for (int j = 1; j < 4; ++j) { A_[nt][j] = av[j] * A_[nt][j - 1]; B_[nt][j] = av[j] * B_[nt][j - 1] + bv[j]; }
                const float tA = A_[nt][3], tB = B_[nt][3];
                const float gA0 = __shfl(tA, fr), gB0 = __shfl(tB, fr), gA1 = __shfl(tA, fr + 16), gB1 = __shfl(tB, fr + 16);
                const float gA2 = __shfl(tA, fr + 32), gB2 = __shfl(tB, fr + 32), gA3 = __shfl(tA, fr + 48), gB3 = __shfl(tB, fr + 48);
                const float c2A = gA1 * gA0, c2B = gA1 * gB0 + gB1, c3A = gA2 * c2A, c3B = gA2 * c2B + gB2;
                float tilA = gA3 * c3A, tilB = gA3 * c3B + gB3;
                cA[nt] = fq == 0 ? 1.f : (fq == 1 ? gA0 : (fq == 2 ? c2A : c3A)); cB[nt] = fq == 0 ? 0.f : (fq == 1 ? gB0 : (fq == 2 ? c2B : c3B));
                if (w >= nvw) { tilA = 1.f; tilB = 0.f; }
                if (fq == 0) AGG[((c & 1) * 8 + w) * 48 + nt * 16 + fr] = (f32x2){tilA, tilB};
            }
        }
        __syncthreads();
#pragma unroll
        for (int nt = 0; nt < 3; ++nt) { float hcur = hc[nt], hst = hc[nt];
#pragma unroll
            for (int ww = 0; ww < 8; ++ww) { const f32x2 ag = AGG[((c & 1) * 8 + ww) * 48 + nt * 16 + fr]; if (ww == w) hst = hcur; hcur = ag.y + ag.x * hcur; }
            hc[nt] = hcur;
            if (w < nvw) { const float hb = cB[nt] + cA[nt] * hst;
#pragma unroll
                for (int j = 0; j < 4; ++j) { const float hj = B_[nt][j] + A_[nt][j] * hb; const int t = 128 * c + 16 * w + 4 * fq + j;
                    if (valid[nt] && (b == 0 || t >= NMETA)) A2[LRU_ROW(t) * DR + chg[nt]] = (bf16)f2bf(hj * gg[nt][j]); } } }
        if (c < 16) LRU_PUT(pf);
        __syncthreads();
    }
    if (w == 0 && fq == 0) {
#pragma unroll
        for (int nt = 0; nt < 3; ++nt) if (valid[nt]) C.out[O_LHP + (size_t)b * DR + chg[nt]] = hc[nt]; }
    if (tid < 3 * 48) { const int k = tid / 48, cl = 48 * half + tid % 48;
        if (cl < 88) C.out[O_LCP + ((size_t)b * 3 + k) * DR + ch0 + cl] = bf2f(XG[((size_t)b * SEQ + (SEQ - 3 + k)) * 2816 + ch0 + cl]); }
    if (b == 0) {
        const float* cs = C.in[I_LC]; const float* h0 = C.in[I_LH];
#pragma unroll
        for (int q = 0; q < 3; ++q) { const int e = tid + 512 * q;
            if (e < 11 * 128) { const int pc = e >> 7, i = e & 127, c8 = ch0 + pc * 8; float acc[8], xs[4][8];
                { const v4u xv = *(const GAS v4u*)(XG + (size_t)(R_SMP + i) * 2816 + c8);
                  xs[3][0] = bflo(xv.x); xs[3][1] = bfhi(xv.x); xs[3][2] = bflo(xv.y); xs[3][3] = bfhi(xv.y); xs[3][4] = bflo(xv.z); xs[3][5] = bfhi(xv.z); xs[3][6] = bflo(xv.w); xs[3][7] = bfhi(xv.w); }
#pragma unroll
                for (int k = 0; k < 3; ++k) { const f32x4 s0 = *(const GAS f32x4*)(cs + ((size_t)i * 3 + k) * DR + c8), s1 = *(const GAS f32x4*)(cs + ((size_t)i * 3 + k) * DR + c8 + 4);
                    xs[k][0] = s0.x; xs[k][1] = s0.y; xs[k][2] = s0.z; xs[k][3] = s0.w; xs[k][4] = s1.x; xs[k][5] = s1.y; xs[k][6] = s1.z; xs[k][7] = s1.w; }
#pragma unroll
                for (int u = 0; u < 8; ++u) { acc[u] = CW[4 * 96 + pc * 8 + u];
#pragma unroll
                    for (int k = 0; k < 4; ++k) acc[u] += CW[k * 96 + pc * 8 + u] * xs[k][u]; }
                v4u o; o.x = pk2(acc[0], acc[1]); o.y = pk2(acc[2], acc[3]); o.z = pk2(acc[4], acc[5]); o.w = pk2(acc[6], acc[7]);
                *(LAS v4u*)(XCA + i * 104 + pc * 8) = o;
                *(LAS f32x4*)(XCF + i * 100 + pc * 8) = (f32x4){acc[0], acc[1], acc[2], acc[3]}; *(LAS f32x4*)(XCF + i * 100 + pc * 8 + 4) = (f32x4){acc[4], acc[5], acc[6], acc[7]};
                if (half == 0) {
#pragma unroll
                    for (int k = 0; k < 3; ++k) { float* op = C.out + O_LCS + ((size_t)i * 3 + k) * DR + c8;
                        *(GAS f32x4*)op = (f32x4){xs[k + 1][0], xs[k + 1][1], xs[k + 1][2], xs[k + 1][3]}; *(GAS f32x4*)(op + 4) = (f32x4){xs[k + 1][4], xs[k + 1][5], xs[k + 1][6], xs[k + 1][7]}; } } } }
        __syncthreads();
        bf16x8 a[3];
#pragma unroll
        for (int ks = 0; ks < 3; ++ks) a[ks] = *(const LAS bf16x8*)(XCA + (16 * w + fr) * 104 + ks * 32 + fq * 8);
#pragma unroll
        for (int nt = 0; nt < 3; ++nt) {
            f32x4 accR = {0.f, 0.f, 0.f, 0.f}, accI = {0.f, 0.f, 0.f, 0.f};
#pragma unroll
            for (int ks = 0; ks < 3; ++ks) { accR = __builtin_amdgcn_mfma_f32_16x16x32_bf16(a[ks], bA[nt][ks], accR, 0, 0, 0);
                accI = __builtin_amdgcn_mfma_f32_16x16x32_bf16(a[ks], bX[nt][ks], accI, 0, 0, 0); }
#pragma unroll
            for (int j = 0; j < 4; ++j) { const int i = 16 * w + 4 * fq + j; const float xc = XCF[i * 100 + cll[nt]];
                const float r = sigmoid_f(accR[j] + ba[nt]), ig = sigmoid_f(accI[j] + bx[nt]);
                const float aa = __builtin_amdgcn_exp2f(c1[nt] * r);
                const float om = __builtin_fmaf(-aa, aa, 1.0f);
                const float bb = __builtin_amdgcn_sqrtf(om > 0.f ? om : 0.f) * (ig * xc);
                const float hn = aa * h0[(size_t)i * DR + chg[nt]] + bb;
                const float g1 = bf2f(XG[(size_t)(R_SMP + i) * 2816 + DR + chg[nt]]);
                if (valid[nt]) { A2[(size_t)(R_SMP + i) * DR + chg[nt]] = (bf16)f2bf(hn * g1); C.out[O_LHS + (size_t)i * DR + chg[nt]] = hn; } }
        }
    }
#undef LRU_ROW
#undef LRU_LOAD
#undef LRU_PUT
}

constexpr int S5_UL = 0, S5_HB = 76032;
#define CMUL_R(ar, ai, br, bi) ((ar) * (br) - (ai) * (bi))
#define CMUL_I(ar, ai, br, bi) ((ar) * (bi) + (ai) * (br))
__device__ __forceinline__ void s5_item(const Ctx& C, int it) {
    const int tid = C.tid, lane = C.lane, w = C.wave, fr = lane & 15, fq = lane >> 4;
    const bool smp = it >= 512; const int g = smp ? it - 512 : (it & 63), b = smp ? 0 : (it >> 6);
    const int rb0 = smp ? 1032 : b * 129, nrow = smp ? 128 : 129, nm = smp ? 8 : 9;
    LAS bf16* UL = (LAS bf16*)(C.lds + RING_OFF + S5_UL); LAS bf16* HB = (LAS bf16*)(C.lds + RING_OFF + S5_HB);
    const bf16* U = (const bf16*)(C.ws + WS_R1) + ((size_t)rb0 * 64 + g) * 256;
    const bf16* WE = (const bf16*)(C.ws + WS_S5WE) + (size_t)g * 128 * 256; const bf16* WY = (const bf16*)(C.ws + WS_S5WY) + (size_t)g * 256 * 384;
    const float* S5C = (const float*)(C.ws + WS_S5C); bf16* Z = (bf16*)(C.ws + WS_R2);
    __syncthreads();
    for (int e = tid; e < nrow * 32; e += 512) { const int row = e >> 5, pc = e & 31; *(LAS v4u*)(UL + row * 264 + pc * 8) = *(const GAS v4u*)(U + (size_t)row * 16384 + pc * 8); }
    __syncthreads();
    if (w < 4) {
        const int p = 16 * w + fr;
        bf16x8 bRe[8], bIm[8];
#pragma unroll
        for (int ks = 0; ks < 8; ++ks) { bRe[ks] = *(const GAS bf16x8*)(WE + (size_t)p * 256 + ks * 32 + fq * 8); bIm[ks] = *(const GAS bf16x8*)(WE + (size_t)(64 + p) * 256 + ks * 32 + fq * 8); }
        if (!smp) {
            const float q1r = S5C[0 * 4096 + g * 64 + p], q1i = S5C[1 * 4096 + g * 64 + p];
            const float q2r = CMUL_R(q1r, q1i, q1r, q1i), q2i = CMUL_I(q1r, q1i, q1r, q1i);
            const float q4r = CMUL_R(q2r, q2i, q2r, q2i), q4i = CMUL_I(q2r, q2i, q2r, q2i);
            const float q8r = CMUL_R(q4r, q4i, q4r, q4i), q8i = CMUL_I(q4r, q4i, q4r, q4i);
            const float q16r = CMUL_R(q8r, q8i, q8r, q8i), q16i = CMUL_I(q8r, q8i, q8r, q8i);
            const float q12r = CMUL_R(q4r, q4i, q8r, q8i), q12i = CMUL_I(q4r, q4i, q8r, q8i);
            const float qfr = fq == 0 ? 1.f : (fq == 1 ? q4r : (fq == 2 ? q8r : q12r)), qfi = fq == 0 ? 0.f : (fq == 1 ? q4i : (fq == 2 ? q8i : q12i));
            float Hsr = 0.f, Hsi = 0.f;
            for (int m = 0; m < 9; ++m) {
                f32x4 aR = {0.f, 0.f, 0.f, 0.f}, aI = {0.f, 0.f, 0.f, 0.f};
#pragma unroll
                for (int ks = 0; ks < 8; ++ks) { const bf16x8 a = *(const LAS bf16x8*)(UL + (16 * m + fr) * 264 + ks * 32 + fq * 8);
                    aR = __builtin_amdgcn_mfma_f32_16x16x32_bf16(a, bRe[ks], aR, 0, 0, 0); aI = __builtin_amdgcn_mfma_f32_16x16x32_bf16(a, bIm[ks], aI, 0, 0, 0); }
                float Lr = aR[0], Li = aI[0];
#pragma unroll
                for (int j = 1; j < 4; ++j) { const float nr = CMUL_R(q1r, q1i, Lr, Li) + aR[j], ni = CMUL_I(q1r, q1i, Lr, Li) + aI[j]; Lr = nr; Li = ni; }
                const float T0r = __shfl(Lr, fr), T0i = __shfl(Li, fr), T1r = __shfl(Lr, fr + 16), T1i = __shfl(Li, fr + 16);
                const float T2r = __shfl(Lr, fr + 32), T2i = __shfl(Li, fr + 32), T3r = __shfl(Lr, fr + 48), T3i = __shfl(Li, fr + 48);
                const float c2r = CMUL_R(q4r, q4i, T0r, T0i) + T1r, c2i = CMUL_I(q4r, q4i, T0r, T0i) + T1i;
                const float c3r = CMUL_R(q4r, q4i, c2r, c2i) + T2r, c3i = CMUL_I(q4r, q4i, c2r, c2i) + T2i;
                const float ttr = CMUL_R(q4r, q4i, c3r, c3i) + T3r, tti = CMUL_I(q4r, q4i, c3r, c3i) + T3i;
                const float cfr = fq == 0 ? 0.f : (fq == 1 ? T0r : (fq == 2 ? c2r : c3r)), cfi = fq == 0 ? 0.f : (fq == 1 ? T0i : (fq == 2 ? c2i : c3i));
                float sr = CMUL_R(qfr, qfi, Hsr, Hsi) + cfr, si = CMUL_I(qfr, qfi, Hsr, Hsi) + cfi;
#pragma unroll
                for (int j = 0; j < 4; ++j) { const int k = 16 * m + 4 * fq + j;
                    HB[k * 136 + p] = (bf16)f2bf(sr); HB[k * 136 + 64 + p] = (bf16)f2bf(si);
                    const float nr = CMUL_R(q1r, q1i, sr, si) + aR[j], ni = CMUL_I(q1r, q1i, sr, si) + aI[j]; sr = nr; si = ni;
                    if (m == 8 && j == 0 && fq == 0) { C.out[O_SRP + ((size_t)b * 64 + g) * 64 + p] = sr; C.out[O_SIP + ((size_t)b * 64 + g) * 64 + p] = si; } }
                const float nHr = CMUL_R(q16r, q16i, Hsr, Hsi) + ttr, nHi = CMUL_I(q16r, q16i, Hsr, Hsi) + tti; Hsr = nHr; Hsi = nHi;
            }
        } else {
            const float a1r = S5C[2 * 4096 + g * 64 + p], a1i = S5C[3 * 4096 + g * 64 + p], mr = S5C[4 * 4096 + g * 64 + p], mi = S5C[5 * 4096 + g * 64 + p];
            for (int m = 0; m < 8; ++m) {
                f32x4 aR = {0.f, 0.f, 0.f, 0.f}, aI = {0.f, 0.f, 0.f, 0.f};
#pragma unroll
                for (int ks = 0; ks < 8; ++ks) { const bf16x8 a = *(const LAS bf16x8*)(UL + (16 * m + fr) * 264 + ks * 32 + fq * 8);
                    aR = __builtin_amdgcn_mfma_f32_16x16x32_bf16(a, bRe[ks], aR, 0, 0, 0); aI = __builtin_amdgcn_mfma_f32_16x16x32_bf16(a, bIm[ks], aI, 0, 0, 0); }
#pragma unroll
                for (int j = 0; j < 4; ++j) { const int i = 16 * m + 4 * fq + j;
                    const float h0r = C.in[I_SRE][((size_t)i * 64 + g) * 64 + p], h0i = C.in[I_SIM][((size_t)i * 64 + g) * 64 + p];
                    HB[i * 136 + p] = (bf16)f2bf(h0r); HB[i * 136 + 64 + p] = (bf16)f2bf(h0i);
                    C.out[O_SRS + ((size_t)i * 64 + g) * 64 + p] = CMUL_R(a1r, a1i, h0r, h0i) + CMUL_R(mr, mi, aR[j], aI[j]);
                    C.out[O_SIS + ((size_t)i * 64 + g) * 64 + p] = CMUL_I(a1r, a1i, h0r, h0i) + CMUL_I(mr, mi, aR[j], aI[j]); }
            }
        }
    }
    __syncthreads();
    const f32x4 dsk = *(const GAS f32x4*)(C.in[I_SD] + 16 * g + 4 * fq);
    if (!smp) {
        bf16x8 bY[2][12];
#pragma unroll
        for (int nt = 0; nt < 2; ++nt)
#pragma unroll
            for (int ks = 0; ks < 12; ++ks) bY[nt][ks] = *(const GAS bf16x8*)(WY + (size_t)(16 * (2 * w + nt) + fr) * 384 + ks * 32 + fq * 8);
        for (int m = 0; m < 9; ++m) {
            f32x4 acc[2] = {{0.f, 0.f, 0.f, 0.f}, {0.f, 0.f, 0.f, 0.f}};
#pragma unroll
            for (int ks = 0; ks < 12; ++ks) { bf16x8 a;
                if (ks < 8) a = *(const LAS bf16x8*)(UL + (16 * m + fr) * 264 + ks * 32 + fq * 8); else a = *(const LAS bf16x8*)(HB + (16 * m + fr) * 136 + (ks - 8) * 32 + fq * 8);
                acc[0] = __builtin_amdgcn_mfma_f32_16x16x32_bf16(bY[0][ks], a, acc[0], 0, 0, 0);
                acc[1] = __builtin_amdgcn_mfma_f32_16x16x32_bf16(bY[1][ks], a, acc[1], 0, 0, 0); }
            const int rl = 16 * m + fr;
            if (rl < 129 && (rl > 0 || b == 0)) {
#pragma unroll
                for (int nt = 0; nt < 2; ++nt) { const int t = 2 * w + nt;
                    const v2u xw = *(const LAS v2u*)(UL + rl * 264 + t * 16 + 4 * fq);
                    const float z0 = gelu_tanh_f(acc[nt][0] + dsk.x * bflo(xw.x)), z1 = gelu_tanh_f(acc[nt][1] + dsk.y * bfhi(xw.x));
                    const float z2 = gelu_tanh_f(acc[nt][2] + dsk.z * bflo(xw.y)), z3 = gelu_tanh_f(acc[nt][3] + dsk.w * bfhi(xw.y));
                    const size_t row = (rl == 0) ? (size_t)(R_META + t) : (size_t)b * SEQ + 16 * (rl - 1) + t;
                    v2u o; o.x = pk2(z0, z1); o.y = pk2(z2, z3);
                    *(GAS v2u*)(Z + row * D + 16 * g + 4 * fq) = o; } }
        }
    } else {
        bf16x8 bY0[12];
#pragma unroll
        for (int ks = 0; ks < 12; ++ks) bY0[ks] = *(const GAS bf16x8*)(WY + (size_t)fr * 384 + ks * 32 + fq * 8);
        f32x4 acc = {0.f, 0.f, 0.f, 0.f};
#pragma unroll
        for (int ks = 0; ks < 12; ++ks) { bf16x8 a;
            if (ks < 8) a = *(const LAS bf16x8*)(UL + (16 * w + fr) * 264 + ks * 32 + fq * 8); else a = *(const LAS bf16x8*)(HB + (16 * w + fr) * 136 + (ks - 8) * 32 + fq * 8);
            acc = __builtin_amdgcn_mfma_f32_16x16x32_bf16(bY0[ks], a, acc, 0, 0, 0); }
        const int i = 16 * w + fr;
        const v2u xw = *(const LAS v2u*)(UL + i * 264 + 4 * fq);
        const float z0 = gelu_tanh_f(acc[0] + dsk.x * bflo(xw.x)), z1 = gelu_tanh_f(acc[1] + dsk.y * bfhi(xw.x));
        const float z2 = gelu_tanh_f(acc[2] + dsk.z * bflo(xw.y)), z3 = gelu_tanh_f(acc[3] + dsk.w * bfhi(xw.y));
        v2u o; o.x = pk2(z0, z1); o.y = pk2(z2, z3);
        *(GAS v2u*)(Z + (size_t)(R_SMP + i) * D + 16 * g + 4 * fq) = o;
    }
}

constexpr int N_PHASES = 14;
#ifndef DUP_MASK
#define DUP_MASK 0
#endif
#define NREP(k) (((DUP_MASK >> (k)) & 1) ? 2 : 1)
__global__ void __launch_bounds__(NWAVES * 64, 2) hybrid_fwd(Args args) {
    extern __shared__ __attribute__((aligned(16))) unsigned char lds_raw[];
    Ctx C;
    C.lds = (LAS unsigned char*)lds_raw;
    C.tid = threadIdx.x; C.lane = C.tid & 63; C.wave = __builtin_amdgcn_readfirstlane(C.tid >> 6);
    C.G = gridDim.x; { const int bx = blockIdx.x; C.vcu = (C.G % 8 == 0) ? (bx % 8) * (C.G / 8) + bx / 8 : bx; }
    C.in = args.in; C.out = args.out; C.ws = args.ws;
    volatile LAS unsigned* MISC = (volatile LAS unsigned*)(C.lds + MISC_OFF);
    for (int u = C.tid; u < (LDS_BYTES - LDSCTL_OFF) / 4; u += NWAVES * 64) ((LAS unsigned*)(C.lds + LDSCTL_OFF))[u] = 0u;
    __syncthreads();
    const int lo = args.ph_lo, hi = args.ph_hi;
    XcdBarrier bar; bar.bar = (unsigned*)(C.ws + WS_CTL) + CW_BAR; bar.x = 0; bar.st = nullptr;
    if (hi - lo > 1) bar = xcd_barrier_post((unsigned*)(C.ws + WS_CTL) + CW_BAR, MISC + 8);
#define IN(k) (lo <= (k) && (k) < hi)
#define SEAM(k) do { if (IN(k) && IN((k) + 1)) xcd_barrier(bar); } while (0)
    const float* gain = args.in[I_GAIN];
    bf16* XN = (bf16*)(C.ws + WS_XN); bf16* R1 = (bf16*)(C.ws + WS_R1); bf16* R2 = (bf16*)(C.ws + WS_R2);

    if (IN(0)) { p0_prologue(C); } SEAM(0);
    if (IN(1)) {
        pg8::Gemm g{XN, (const bf16*)(C.ws + WS_W1T), MROWS, 2816, 1024, 1024}; pg8::StaticOrder S; S.init(MROWS, 2816, C.G, (int)blockIdx.x);
        pg8::EpiXG E{R1};
        pg8::gemm_phase<pg8::EpiXG, pg8::StaticOrder, PG8_ALIGN, PG8_SP2>(C.lds + RING_OFF, g, S, E);
    } SEAM(1);
    if (IN(2)) {
        lru2_block(C);
    } SEAM(2);
    if (IN(3)) {
        pg8::Gemm g{R2, (const bf16*)(C.ws + WS_W2T), 16384, 1024, 1408, 1408}; pg8::StaticOrder S; S.init(16384, 1024, C.G, (int)blockIdx.x);
        pg8::EpiPlain E{R1, 1024};
        pg8::gemm_phase<pg8::EpiPlain, pg8::StaticOrder, PG8_ALIGN, PG8_SP2>(C.lds + RING_OFF, g, S, E);
        pg8::Gemm g2{R2, (const bf16*)(C.ws + WS_W2T), MROWS, 1024, 128, 1408}; pg8::SplitOrder S2{4, 11, 128, C.G, (int)blockIdx.x, 64};
        pg8::EpiSlab E2{(float*)(C.ws + WS_SLAB), 1024};
        pg8::gemm_phase<pg8::EpiSlab, pg8::SplitOrder, PG8_ALIGN, PG8_SP2>(C.lds + RING_OFF, g2, S2, E2);
    } SEAM(3);
    if (IN(4)) { nr_phase<0>(C, R1, gain + 1 * D, gain + 2 * D, 11, 1024, false); } SEAM(4);
    if (IN(5)) {
        pg8::Gemm g{XN, (const bf16*)(C.ws + WS_W3T), MROWS, 5632, 1024, 1024}; pg8::StaticOrder S; S.init(MROWS, 5632, C.G, (int)blockIdx.x);
        pg8::EpiGated<0> E{R1, 2816};
        pg8::gemm_phase<pg8::EpiGated<0>, pg8::StaticOrder, PG8_ALIGN, PG8_SP2>(C.lds + RING_OFF, g, S, E);
    } SEAM(5);
    if (IN(6)) {
        pg8::Gemm g{R1, (const bf16*)(C.ws + WS_W4T), 16384, 1024, 2816, 2816}; pg8::StaticOrder S; S.init(16384, 1024, C.G, (int)blockIdx.x);
        pg8::EpiPlain E{R2, 1024};
        pg8::gemm_phase<pg8::EpiPlain, pg8::StaticOrder, PG8_ALIGN, PG8_SP2>(C.lds + RING_OFF, g, S, E);
        pg8::Gemm g2{R1, (const bf16*)(C.ws + WS_W4T), MROWS, 1024, 256, 2816}; pg8::SplitOrder S2{4, 11, 256, C.G, (int)blockIdx.x, 64};
        pg8::EpiSlab E2{(float*)(C.ws + WS_SLAB), 1024};
        pg8::gemm_phase<pg8::EpiSlab, pg8::SplitOrder, PG8_ALIGN, PG8_SP2>(C.lds + RING_OFF, g2, S2, E2);
    } SEAM(6);
    if (IN(7)) { nr_phase<1>(C, R2, gain + 3 * D, gain + 4 * D, 11, 1024, false); } SEAM(7);
    if (IN(8)) {
        for (int it = C.vcu; it < 576; it += C.G) s5_item(C, it);
    } SEAM(8);
    if (IN(9)) {
        pg8::Gemm g{R2, (const bf16*)(C.ws + WS_W5T), 16384, 2048, 1024, 1024}; pg8::StaticOrder S; S.init(16384, 2048, C.G, (int)blockIdx.x);
        pg8::EpiGated<1> E{R1, 1024};
        pg8::gemm_phase<pg8::EpiGated<1>, pg8::StaticOrder, PG8_ALIGN, PG8_SP2>(C.lds + RING_OFF, g, S, E);
        pg8::Gemm g2{R2, (const bf16*)(C.ws + WS_W5T), MROWS, 2048, 256, 1024}; pg8::SplitOrder S2{8, 4, 256, C.G, (int)blockIdx.x, 64};
        pg8::EpiSlab E2{(float*)(C.ws + WS_SLAB), 2048};
        pg8::gemm_phase<pg8::EpiSlab, pg8::SplitOrder, PG8_ALIGN, PG8_SP2>(C.lds + RING_OFF, g2, S2, E2);
    } SEAM(9);
    if (IN(10)) { nr_phase<2>(C, R1, gain + 5 * D, gain + 6 * D, 4, 2048, true); } SEAM(10);
    if (IN(11)) {
        pg8::Gemm g{XN, (const bf16*)(C.ws + WS_W3T) + (size_t)5632 * 1024, MROWS, 5632, 1024, 1024}; pg8::StaticOrder S; S.init(MROWS, 5632, C.G, (int)blockIdx.x);
        pg8::EpiGated<0> E{R1, 2816};
        pg8::gemm_phase<pg8::EpiGated<0>, pg8::StaticOrder, PG8_ALIGN, PG8_SP2>(C.lds + RING_OFF, g, S, E);
    } SEAM(11);
    if (IN(12)) {
        pg8::Gemm g{R1, (const bf16*)(C.ws + WS_W4T) + (size_t)1024 * 2816, 16384, 1024, 2816, 2816}; pg8::StaticOrder S; S.init(16384, 1024, C.G, (int)blockIdx.x);
        pg8::EpiPlain E{R2, 1024};
        pg8::gemm_phase<pg8::EpiPlain, pg8::StaticOrder, PG8_ALIGN, PG8_SP2>(C.lds + RING_OFF, g, S, E);
        pg8::Gemm g2{R1, (const bf16*)(C.ws + WS_W4T) + (size_t)1024 * 2816, MROWS, 1024, 256, 2816}; pg8::SplitOrder S2{4, 11, 256, C.G, (int)blockIdx.x, 64};
        pg8::EpiSlab E2{(float*)(C.ws + WS_SLAB), 1024};
        pg8::gemm_phase<pg8::EpiSlab, pg8::SplitOrder, PG8_ALIGN, PG8_SP2>(C.lds + RING_OFF, g2, S2, E2);
    } SEAM(12);
    if (IN(13)) { nr_phase<3>(C, R2, gain + 7 * D, gain, 11, 1024, false); }
#undef IN
#undef SEAM
}

#ifndef MK_ONE_LAUNCH
#define MK_ONE_LAUNCH 1
#endif
extern "C" void kernel_launch(void* const* d_in, const int* in_sizes, int n_in, void* d_out, int out_size, void* d_ws, size_t ws_size, hipStream_t stream) {
    static int grid = 0;
    if (grid == 0) {
        if (n_in != 28 || out_size != (int)O_END || ws_size < WS_END) { fprintf(stderr, "kernel_launch: unexpected shapes: n_in %d out %d ws %zu (need %zu)\n", n_in, out_size, ws_size, (size_t)WS_END); grid = -1; return; }
        int dev = 0, cus = 0, per_cu = 0;
        if (hipGetDevice(&dev) != hipSuccess || hipDeviceGetAttribute(&cus, hipDeviceAttributeMultiprocessorCount, dev) != hipSuccess) { grid = -1; return; }
        if (hipFuncSetAttribute((const void*)hybrid_fwd, hipFuncAttributeMaxDynamicSharedMemorySize, LDS_BYTES) != hipSuccess) { fprintf(stderr, "kernel_launch: hipFuncSetAttribute failed\n"); grid = -1; return; }
        if (hipOccupancyMaxActiveBlocksPerMultiprocessor(&per_cu, (const void*)hybrid_fwd, NWAVES * 64, LDS_BYTES) != hipSuccess || per_cu < 1) { fprintf(stderr, "kernel_launch: occupancy query says %d\n", per_cu); }
        (void)hipGetLastError();
        grid = cus;
        if (grid != 256) fprintf(stderr, "kernel_launch: %d CUs (built for 256)\n", grid);
    }
    if (grid < 0) return;
    (void)in_sizes;
    if (hipMemsetAsync((char*)d_ws + WS_CTL, 0, CTL_ZERO_BYTES, stream) != hipSuccess) return;
    Args a{};
    for (int i = 0; i < 28; ++i) a.in[i] = (const float*)d_in[i];
    a.out = (float*)d_out; a.ws = (unsigned char*)d_ws;
#if MK_ONE_LAUNCH
    a.ph_lo = 0; a.ph_hi = N_PHASES;
    hipLaunchKernelGGL(hybrid_fwd, dim3(grid), dim3(NWAVES * 64), LDS_BYTES, stream, a);
#else
    for (int p = 0; p < N_PHASES; ++p) for (int rep = 0; rep < NREP(p); ++rep) { a.ph_lo = p; a.ph_hi = p + 1;
        hipLaunchKernelGGL(hybrid_fwd, dim3(grid), dim3(NWAVES * 64), LDS_BYTES, stream, a); }
#endif
}
```

```cpp
#include <hip/hip_runtime.h>
#include <cstdio>
#include <cstdint>
namespace pg8 {
#define PG8_LAS __attribute__((address_space(3)))
typedef unsigned short bf16_t;
typedef short bf16x8 __attribute__((ext_vector_type(8)));
typedef float f32x4 __attribute__((ext_vector_type(4)));
typedef unsigned u32x4 __attribute__((ext_vector_type(4)));
constexpr int BM = 256, BK = 64, HALF = 128, HTB = HALF * BK * 2  , STAGE_BYTES = 8 * HTB, NXCD = 8, WGM = 8;

__host__ __device__ __forceinline__ int lds_byte(int r, int c) { const int st = (r >> 4) * 2 + (c >> 5), rr = r & 15, cc = c & 31, ob = rr * 64 + cc * 2; return st * 1024 + (ob ^ (((ob >> 9) & 1) << 5)); }
__host__ __device__ __forceinline__ void stage_rc(int b, int& R, int& C) { const int st = b / 1024, sb = b % 1024, swz = sb ^ (((sb >> 9) & 1) << 5); R = (st >> 1) * 16 + swz / 64; C = (st & 1) * 32 + (swz % 64) / 2; }
__host__ __device__ __forceinline__ int perm32(int rho) { const int n = rho >> 4, i = rho & 15; return 8 * (i >> 2) + 4 * n + (i & 3); }

struct Unit { int pm, pn, koff, ks; };
struct Gemm { const bf16_t* A; const bf16_t* Bt; int M, N, K, ld; };

struct StaticOrder {
    int nM, nN, nwg, G, c;
    __host__ __device__ void init(int M, int N, int G_, int c_) { nM = M / BM; nN = N / BM; nwg = nM * nN; G = G_; c = c_; }
    __host__ __device__ bool next(int i, Unit& u) const {
        const long L = (long)i * G + c; if (L >= nwg) return false;
        int wgid = (int)L; { const int q = nwg / NXCD, r = nwg % NXCD, xcd = wgid % NXCD, off = wgid / NXCD; wgid = (xcd < r ? xcd * (q + 1) : r * (q + 1) + (xcd - r) * q) + off; }
        const int nig = WGM * nN, gid = wgid / nig, fm = gid * WGM, gsz = (nM - fm) < WGM ? (nM - fm) : WGM;
        u.pm = fm + ((wgid % nig) % gsz); u.pn = (wgid % nig) / gsz; u.koff = 0; u.ks = 0; return true;
    }
    __device__ __forceinline__ void a_ready(const Unit&) const {}
    __device__ __forceinline__ void done(const Unit&) const {}
};

__device__ __forceinline__ unsigned cvt_pk_bf16(float lo, float hi) { unsigned r; asm volatile("v_cvt_pk_bf16_f32 %0, %1, %2" : "=v"(r) : "v"(lo), "v"(hi)); return r; }
typedef float f32x2 __attribute__((ext_vector_type(2)));
__device__ __forceinline__ f32x2 gelu_pk(f32x2 v) {
    const f32x2 av = __builtin_elementwise_abs(v), d = av * 0.2316418882f + 1.0f;
    f32x2 t; t.x = __builtin_amdgcn_rcpf(d.x); t.y = __builtin_amdgcn_rcpf(d.y);
    f32x2 q = t * 0.5307027145f + (-0.7265760135f); q = q * t + 0.7107068705f; q = q * t + (-0.142248368f); q = q * t + 0.127414796f; q = q * t;
    const f32x2 s = (v * v) * (-0.72134752044f);
    f32x2 e; e.x = __builtin_amdgcn_exp2f(s.x); e.y = __builtin_amdgcn_exp2f(s.y);
    const f32x2 m = v * (q * e), r = v - m;
    f32x2 o; o.x = v.x < 0.f ? m.x : r.x; o.y = v.y < 0.f ? m.y : r.y; return o;
}

template <int ACT  > struct EpiBf16 {
    static constexpr bool PERM = true, AFTER_DRAIN = false; static_assert(ACT == 0 || ACT == 1, "EpiBf16: ACT is 0 (none) or 1 (gelu_pk)");
    bf16_t* O; int ldc; const float* bias; int split_cols; size_t split_stride; float scale0;
    __device__ __forceinline__ void operator()(const f32x4 (&acc)[2][2][4][2], const Unit& u, int wr, int wc, int fr, int fq) const {
        const int row0 = u.pm * BM + wr * 64 + fr; int colt = u.pn * BM; bf16_t* base = O;
        float sc = 1.f; if (split_cols) { const int t = colt / split_cols; base += (size_t)t * split_stride; colt -= t * split_cols; if (t == 0) sc = scale0; }
        const int col0 = colt + wc * 32 + 8 * fq, bcol0 = u.pn * BM + wc * 32 + 8 * fq;
        f32x4 bv[2][2];
#pragma unroll
        for (int bj = 0; bj < 2; ++bj)
#pragma unroll
            for (int n = 0; n < 2; ++n) bv[bj][n] = bias ? *(const f32x4*)(bias + bcol0 + bj * HALF + 4 * n) : (f32x4){0.f, 0.f, 0.f, 0.f};
#pragma unroll
        for (int ai = 0; ai < 2; ++ai)
#pragma unroll
            for (int m = 0; m < 4; ++m) { bf16_t* rowp = base + (size_t)(row0 + ai * HALF + m * 16) * ldc + col0;
#pragma unroll
                for (int bj = 0; bj < 2; ++bj) { f32x4 v0 = acc[ai][bj][m][0] + bv[bj][0], v1 = acc[ai][bj][m][1] + bv[bj][1];
                    if (ACT == 1) { f32x2 a = gelu_pk((f32x2){v0[0], v0[1]}), b = gelu_pk((f32x2){v0[2], v0[3]}), c = gelu_pk((f32x2){v1[0], v1[1]}), d = gelu_pk((f32x2){v1[2], v1[3]});
                        v0 = (f32x4){a.x, a.y, b.x, b.y}; v1 = (f32x4){c.x, c.y, d.x, d.y}; }
                    v0 = v0 * sc; v1 = v1 * sc; u32x4 w; w.x = cvt_pk_bf16(v0[0], v0[1]); w.y = cvt_pk_bf16(v0[2], v0[3]); w.z = cvt_pk_bf16(v1[0], v1[1]); w.w = cvt_pk_bf16(v1[2], v1[3]);
                    *(u32x4*)(rowp + bj * HALF) = w; } }
    }
};

__device__ __forceinline__ float gelu_tanh_f(float x) {
    const float u = x * (1.0f + 0.044715f * x * x);
    const float e = __builtin_amdgcn_exp2f(-2.302208198f * u);
    return x * __builtin_amdgcn_rcpf(1.0f + e);
}
__device__ __forceinline__ float sigmoid_f(float x) { return __builtin_amdgcn_rcpf(1.0f + __builtin_amdgcn_exp2f(-1.442695041f * x)); }

struct EpiXG {
    static constexpr bool PERM = true, AFTER_DRAIN = false;
    bf16_t* O; const float* rstd;
    __device__ __forceinline__ void operator()(const f32x4 (&acc)[2][2][4][2], const Unit& u, int wr, int wc, int fr, int fq) const {
        const int row0 = u.pm * BM + wr * 64 + fr, col0 = u.pn * BM + wc * 32 + 8 * fq;
#pragma unroll
        for (int ai = 0; ai < 2; ++ai)
#pragma unroll
            for (int m = 0; m < 4; ++m) { bf16_t* rowp = O + (size_t)(row0 + ai * HALF + m * 16) * 2816 + col0; const float rs = rstd[row0 + ai * HALF + m * 16];
#pragma unroll
                for (int bj = 0; bj < 2; ++bj) { f32x4 v0 = acc[ai][bj][m][0] * rs, v1 = acc[ai][bj][m][1] * rs;
                    if (u.pn * BM + bj * HALF >= 1408) {
#pragma unroll
                        for (int j = 0; j < 4; ++j) { v0[j] = gelu_tanh_f(v0[j]); v1[j] = gelu_tanh_f(v1[j]); } }
                    u32x4 w; w.x = cvt_pk_bf16(v0[0], v0[1]); w.y = cvt_pk_bf16(v0[2], v0[3]); w.z = cvt_pk_bf16(v1[0], v1[1]); w.w = cvt_pk_bf16(v1[2], v1[3]);
                    *(u32x4*)(rowp + bj * HALF) = w; } }
    }
};
template <int ACT> struct EpiGated {
    static constexpr bool PERM = true, AFTER_DRAIN = false;
    bf16_t* O; int ldc; const float* rstd;
    __device__ __forceinline__ void operator()(const f32x4 (&acc)[2][2][4][2], const Unit& u, int wr, int wc, int fr, int fq) const {
        const int row0 = u.pm * BM + wr * 64 + fr, col0 = u.pn * HALF + wc * 32 + 8 * fq;
#pragma unroll
        for (int ai = 0; ai < 2; ++ai)
#pragma unroll
            for (int m = 0; m < 4; ++m) { bf16_t* rowp = O + (size_t)(row0 + ai * HALF + m * 16) * ldc + col0;
                const float rs = rstd ? rstd[row0 + ai * HALF + m * 16] : 1.0f;
                f32x4 o[2];
#pragma unroll
                for (int n = 0; n < 2; ++n)
#pragma unroll
                    for (int j = 0; j < 4; ++j) { const float a = acc[ai][0][m][n][j] * rs, b = acc[ai][1][m][n][j] * rs;
                        o[n][j] = (ACT == 0) ? (a * sigmoid_f(a)) * b : a * sigmoid_f(b); }
                u32x4 w; w.x = cvt_pk_bf16(o[0][0], o[0][1]); w.y = cvt_pk_bf16(o[0][2], o[0][3]); w.z = cvt_pk_bf16(o[1][0], o[1][1]); w.w = cvt_pk_bf16(o[1][2], o[1][3]);
                *(u32x4*)rowp = w; }
    }
};
struct EpiPlain {
    static constexpr bool PERM = true, AFTER_DRAIN = false;
    bf16_t* O; int ldc;
    __device__ __forceinline__ void operator()(const f32x4 (&acc)[2][2][4][2], const Unit& u, int wr, int wc, int fr, int fq) const {
        const int row0 = u.pm * BM + wr * 64 + fr, col0 = u.pn * BM + wc * 32 + 8 * fq;
#pragma unroll
        for (int ai = 0; ai < 2; ++ai)
#pragma unroll
            for (int m = 0; m < 4; ++m) { bf16_t* rowp = O + (size_t)(row0 + ai * HALF + m * 16) * ldc + col0;
#pragma unroll
                for (int bj = 0; bj < 2; ++bj) { const f32x4 v0 = acc[ai][bj][m][0], v1 = acc[ai][bj][m][1];
                    u32x4 w; w.x = cvt_pk_bf16(v0[0], v0[1]); w.y = cvt_pk_bf16(v0[2], v0[3]); w.z = cvt_pk_bf16(v1[0], v1[1]); w.w = cvt_pk_bf16(v1[2], v1[3]);
                    *(u32x4*)(rowp + bj * HALF) = w; } }
    }
};


struct SplitOrder {
    int nN, S, klen, G, c, pm;
    __device__ __forceinline__ bool next(int i, Unit& u) const { const int L = i * G + c; if (L >= nN * S) return false; u.pm = pm; u.pn = L % nN; u.ks = L / nN; u.koff = u.ks * klen; return true; }
    __device__ __forceinline__ void a_ready(const Unit&) const {}
    __device__ __forceinline__ void done(const Unit&) const {}
};
struct EpiSlab {
    static constexpr bool PERM = false, AFTER_DRAIN = false;
    float* S; int N;
    __device__ __forceinline__ void operator()(const f32x4 (&acc)[2][2][4][2], const Unit& u, int wr, int wc, int fr, int fq) const {
        const int row0 = wr * 64 + fr, col0 = u.pn * BM + wc * 32 + 4 * fq; float* base = S + (size_t)u.ks * 144 * N;
#pragma unroll
        for (int ai = 0; ai < 2; ++ai)
#pragma unroll
            for (int m = 0; m < 4; ++m) { const int r = row0 + ai * HALF + m * 16;
                if (r < 144) { float* rowp = base + (size_t)r * N + col0;
#pragma unroll
                    for (int bj = 0; bj < 2; ++bj)
#pragma unroll
                        for (int n = 0; n < 2; ++n) *(f32x4*)(rowp + bj * HALF + n * 16) = acc[ai][bj][m][n]; } }
    }
};
template <class Epi, class Sched, bool ALIGN_EPI = false, bool SP2 = false>
__device__ __forceinline__ void gemm_phase(PG8_LAS unsigned char* lds, const Gemm g, const Sched& S, const Epi& E) {
    const int tid = threadIdx.x, wid = __builtin_amdgcn_readfirstlane(tid >> 6), lane = tid & 63, wr = wid >> 2, wc = wid & 3, fr = lane & 15, fq = lane >> 4;
    const int K = g.K, nt = K / BK, ld = g.ld;
    unsigned voffA[2], voffB[2];
#pragma unroll
    for (int i = 0; i < 2; ++i) { int R, C; stage_rc(tid * 16 + i * 8192, R, C); const int Rb = Epi::PERM ? ((R & ~31) + perm32(R & 31)) : R;
        voffA[i] = (unsigned)(R * ld + C) * 2u; voffB[i] = (unsigned)(Rb * ld + C) * 2u; }
    const size_t kstep = (size_t)(BK * 2);
    const size_t hstep = (size_t)HALF * ld * 2;
    const size_t tstep = 2 * hstep;
    const unsigned ldsw = (unsigned)wid * 1024u;
    const int aoff = lds_byte(wr * 64 + fr, fq * 8), boff = lds_byte(wc * 32 + fr, fq * 8);
#define PG8_SA(b, h) (((b) * 2 + (h)) * HTB)
#define PG8_SB(b, h) ((4 + (b) * 2 + (h)) * HTB)
#define PG8_STAGE(bufoff, gbase, voff) do { _Pragma("unroll") for (int _i = 0; _i < 2; ++_i) \
        __builtin_amdgcn_global_load_lds((const unsigned*)((const char*)(gbase) + (voff)[_i]), (PG8_LAS unsigned*)(lds + (bufoff) + ldsw + _i * 8192), 16, 0, 0); } while (0)
#define PG8_LDA(dst, b, h) do { _Pragma("unroll") for (int m = 0; m < 4; ++m) _Pragma("unroll") for (int k = 0; k < 2; ++k) dst[m][k] = *(const PG8_LAS bf16x8*)(lds + PG8_SA(b, h) + aoff + m * 2048 + k * 1024); } while (0)
#define PG8_LDB(dst, b, h) do { _Pragma("unroll") for (int n = 0; n < 2; ++n) _Pragma("unroll") for (int k = 0; k < 2; ++k) dst[n][k] = *(const PG8_LAS bf16x8*)(lds + PG8_SB(b, h) + boff + n * 2048 + k * 1024); } while (0)
#define PG8_MMA(ai, bj, At, Bt) do { __builtin_amdgcn_s_setprio(1); _Pragma("unroll") for (int m = 0; m < 4; ++m) _Pragma("unroll") for (int n = 0; n < 2; ++n) _Pragma("unroll") for (int k = 0; k < 2; ++k) \
        acc[ai][bj][m][n] = __builtin_amdgcn_mfma_f32_16x16x32_bf16(Bt[n][k], At[m][k], acc[ai][bj][m][n], 0, 0, 0); __builtin_amdgcn_s_setprio(0); } while (0)
#define PG8_WAIT_V(n) asm volatile("s_waitcnt vmcnt(" #n ")" ::: "memory")
#define PG8_WAIT_L(n) asm volatile("s_waitcnt lgkmcnt(" #n ")" ::: "memory")
#define PG8_BAR __builtin_amdgcn_s_barrier()
#define PG8_SCHED __builtin_amdgcn_sched_barrier(0)
    Unit cur, nxt; int ui = 0;
    if (!S.next(0, cur)) return;
    f32x4 acc[2][2][4][2];
#pragma unroll
    for (int a = 0; a < 2; ++a)
#pragma unroll
        for (int b = 0; b < 2; ++b)
#pragma unroll
            for (int m = 0; m < 4; ++m)
#pragma unroll
                for (int n = 0; n < 2; ++n) acc[a][b][m][n] = (f32x4){0.f, 0.f, 0.f, 0.f};
    bf16x8 At[4][2], B0[2][2], B1[2][2];
    const char* cA = (const char*)g.A + (size_t)cur.pm * tstep + (size_t)cur.koff * 2; const char* cB = (const char*)g.Bt + (size_t)cur.pn * tstep + (size_t)cur.koff * 2;
    S.a_ready(cur);
    if constexpr (SP2) {
        PG8_STAGE(PG8_SB(0, 0), cB, voffB); PG8_STAGE(PG8_SB(0, 1), cB + hstep, voffB); PG8_STAGE(PG8_SA(0, 0), cA, voffA); PG8_STAGE(PG8_SA(0, 1), cA + hstep, voffA);
        if (wr == 1) PG8_BAR;
        PG8_WAIT_V(2); PG8_BAR;
        PG8_STAGE(PG8_SB(1, 0), cB + kstep, voffB); PG8_STAGE(PG8_SA(1, 0), cA + kstep, voffA); PG8_STAGE(PG8_SB(1, 1), cB + hstep + kstep, voffB);
        PG8_WAIT_V(6); PG8_BAR;
    } else {
        PG8_STAGE(PG8_SB(0, 0), cB, voffB); PG8_STAGE(PG8_SA(0, 0), cA, voffA); PG8_STAGE(PG8_SB(0, 1), cB + hstep, voffB); PG8_STAGE(PG8_SA(0, 1), cA + hstep, voffA);
        if (wr == 1) PG8_BAR;
        PG8_WAIT_V(4); PG8_BAR;
        PG8_STAGE(PG8_SB(1, 0), cB + kstep, voffB); PG8_STAGE(PG8_SA(1, 0), cA + kstep, voffA); PG8_STAGE(PG8_SB(1, 1), cB + hstep + kstep, voffB);
        PG8_WAIT_V(6); PG8_BAR;
    }
    for (;;) {
        const bool has_next = S.next(ui + 1, nxt);
        const char* nA = has_next ? (const char*)g.A + (size_t)nxt.pm * tstep + (size_t)nxt.koff * 2 : cA; const char* nB = has_next ? (const char*)g.Bt + (size_t)nxt.pn * tstep + (size_t)nxt.koff * 2 : cB;
        for (int t = 0; t < nt; t += 2) {
            const bool last = (t == nt - 2);
            const char* a1 = cA + (size_t)(t + 1) * kstep;
            const char* a2 = last ? nA : cA + (size_t)(t + 2) * kstep; const char* b2 = last ? nB : cB + (size_t)(t + 2) * kstep;
            const char* a3 = a2 + kstep; const char* b3 = b2 + kstep;
            if (last && has_next) S.a_ready(nxt);
            if constexpr (SP2) {
            PG8_LDB(B0, 0, 0); PG8_LDB(B1, 0, 1); PG8_SCHED; PG8_LDA(At, 0, 0); PG8_STAGE(PG8_SA(1, 1), a1 + hstep, voffA);
            PG8_WAIT_V(8); PG8_WAIT_L(0); PG8_BAR; PG8_MMA(0, 0, At, B0); PG8_MMA(0, 1, At, B1); PG8_BAR; PG8_SCHED;
            PG8_LDA(At, 0, 1); PG8_STAGE(PG8_SB(0, 0), b2, voffB); PG8_STAGE(PG8_SB(0, 1), b2 + hstep, voffB); PG8_STAGE(PG8_SA(0, 0), a2, voffA);
            PG8_WAIT_V(8); PG8_WAIT_L(0); PG8_BAR; PG8_MMA(1, 0, At, B0); PG8_MMA(1, 1, At, B1); PG8_BAR; PG8_SCHED;
            PG8_LDB(B0, 1, 0); PG8_LDB(B1, 1, 1); PG8_SCHED; PG8_LDA(At, 1, 0); PG8_STAGE(PG8_SA(0, 1), a2 + hstep, voffA);
            PG8_WAIT_V(8); PG8_WAIT_L(0); PG8_BAR; PG8_MMA(0, 0, At, B0); PG8_MMA(0, 1, At, B1); PG8_BAR; PG8_SCHED;
            PG8_LDA(At, 1, 1); PG8_STAGE(PG8_SB(1, 0), b3, voffB); PG8_STAGE(PG8_SB(1, 1), b3 + hstep, voffB); PG8_STAGE(PG8_SA(1, 0), a3, voffA);
            PG8_WAIT_V(8); PG8_WAIT_L(0); PG8_BAR; PG8_MMA(1, 0, At, B0); PG8_MMA(1, 1, At, B1); PG8_BAR; PG8_SCHED;
            } else {
            PG8_LDB(B0, 0, 0); PG8_SCHED; PG8_LDA(At, 0, 0); PG8_STAGE(PG8_SA(1, 1), a1 + hstep, voffA);
            PG8_WAIT_L(8); PG8_BAR; PG8_WAIT_L(0); PG8_MMA(0, 0, At, B0); PG8_BAR; PG8_SCHED;
            PG8_LDB(B1, 0, 1); PG8_STAGE(PG8_SB(0, 0), b2, voffB);
            PG8_BAR; PG8_WAIT_L(0); PG8_MMA(0, 1, At, B1); PG8_BAR;
            PG8_LDA(At, 0, 1); PG8_STAGE(PG8_SA(0, 0), a2, voffA);
            PG8_BAR; PG8_WAIT_L(0); PG8_MMA(1, 0, At, B0); PG8_BAR; PG8_SCHED;
            PG8_STAGE(PG8_SB(0, 1), b2 + hstep, voffB);
            PG8_WAIT_V(6); PG8_BAR; PG8_MMA(1, 1, At, B1); PG8_BAR;
            PG8_LDB(B0, 1, 0); PG8_SCHED; PG8_LDA(At, 1, 0); PG8_STAGE(PG8_SA(0, 1), a2 + hstep, voffA);
            PG8_WAIT_L(8); PG8_BAR; PG8_WAIT_L(0); PG8_MMA(0, 0, At, B0); PG8_BAR; PG8_SCHED;
            PG8_LDB(B1, 1, 1); PG8_STAGE(PG8_SB(1, 0), b3, voffB);
            PG8_BAR; PG8_WAIT_L(0); PG8_MMA(0, 1, At, B1); PG8_BAR;
            PG8_LDA(At, 1, 1); PG8_STAGE(PG8_SA(1, 0), a3, voffA);
            PG8_BAR; PG8_WAIT_L(0); PG8_MMA(1, 0, At, B0); PG8_BAR; PG8_SCHED;
            PG8_STAGE(PG8_SB(1, 1), b3 + hstep, voffB);
            PG8_WAIT_V(6); PG8_BAR; PG8_MMA(1, 1, At, B1); PG8_BAR;
            }
        }
        if constexpr (ALIGN_EPI) { if (wr == 0) PG8_BAR; }
        if constexpr (!Epi::AFTER_DRAIN) { E(acc, cur, wr, wc, fr, fq); S.done(cur); }
        if (!has_next) break;
#pragma unroll
        for (int a = 0; a < 2; ++a)
#pragma unroll
            for (int b = 0; b < 2; ++b)
#pragma unroll
                for (int m = 0; m < 4; ++m)
#pragma unroll
                    for (int n = 0; n < 2; ++n) acc[a][b][m][n] = (f32x4){0.f, 0.f, 0.f, 0.f};
        cur = nxt; cA = nA; cB = nB; ++ui;
        if constexpr (ALIGN_EPI) { if (wr == 1) PG8_BAR; }
    }
    PG8_WAIT_V(0);
    if constexpr (!ALIGN_EPI) { if (wr == 0) PG8_BAR; }
    PG8_BAR;
    if constexpr (Epi::AFTER_DRAIN) { E.fused(acc, cur, wr, wc, fr, fq, lds, wid, lane); S.done(cur); }
#undef PG8_SA
#undef PG8_SB
#undef PG8_STAGE
#undef PG8_LDA
#undef PG8_LDB
#undef PG8_MMA
#undef PG8_WAIT_V
#undef PG8_WAIT_L
#undef PG8_BAR
#undef PG8_SCHED
}
}

#ifndef PG8_SP2
#define PG8_SP2 true
#endif
#ifndef PG8_ALIGN
#define PG8_ALIGN true
#endif

constexpr int NWAVES = 8;
constexpr int D = 1024, DR = 1408, DFF = 2816, NBATCH = 8, SEQ = 2048, NMETA = 16, NSMP = 128;
constexpr int LRU_BW = 88;
constexpr int MROWS = 16640;
constexpr int R_META = 16384, R_SMP = 16400, R_END = 16528;
constexpr int S5_RB = 1160;
constexpr float RMS_EPS = 1e-6f;
constexpr size_t O_YP = 0, O_YS = 16777216, O_LHP = 16908288, O_LCP = 16919552, O_SRP = 16953344, O_SIP = 16986112,
                 O_LHS = 17018880, O_LCS = 17199104, O_SRS = 17739776, O_SIS = 18264064, O_END = 18788352;
constexpr size_t al256(size_t x) { return (x + 255) & ~(size_t)255; }
constexpr size_t WS_CTL = 0, CTL_ZERO_BYTES = 1u << 20;
constexpr size_t WS_W1T = CTL_ZERO_BYTES;
constexpr size_t WS_W2T = WS_W1T + (size_t)2816 * 1024 * 2;
constexpr size_t WS_W3T = WS_W2T + (size_t)1024 * 1408 * 2;
constexpr size_t WS_W4T = WS_W3T + (size_t)2 * 5632 * 1024 * 2;
constexpr size_t WS_W5T = WS_W4T + (size_t)2 * 1024 * 2816 * 2;
constexpr size_t WS_WGT = WS_W5T + (size_t)2048 * 1024 * 2;
constexpr size_t WS_S5WE = WS_WGT + (size_t)16 * 2 * 96 * 96 * 2;
constexpr size_t WS_S5WY = WS_S5WE + (size_t)64 * 128 * 256 * 2;
constexpr size_t WS_S5C = WS_S5WY + (size_t)64 * 256 * 384 * 2;
constexpr size_t WS_XEX = WS_S5C + (size_t)6 * 4096 * 4;
constexpr size_t WS_XN = WS_XEX + (size_t)256 * 1024 * 4;
constexpr size_t WS_R1 = WS_XN + (size_t)MROWS * 1024 * 2;
constexpr size_t WS_R2 = WS_R1 + (size_t)MROWS * 2816 * 2;
constexpr size_t WS_SLAB = WS_R2 + (size_t)MROWS * 1408 * 2;
constexpr size_t WS_END = WS_SLAB + (size_t)11 * 144 * 1024 * 4;
static_assert(WS_END <= (size_t)268435456, "d_ws map exceeds 256 MiB");
static_assert((WS_W1T % 256) == 0 && (WS_W2T % 256) == 0 && (WS_W3T % 256) == 0 && (WS_W4T % 256) == 0 && (WS_W5T % 256) == 0 && (WS_WGT % 256) == 0 && (WS_S5WE % 256) == 0 &&
              (WS_S5WY % 256) == 0 && (WS_S5C % 256) == 0 && (WS_XEX % 256) == 0 && (WS_XN % 256) == 0 && (WS_R1 % 256) == 0 && (WS_R2 % 256) == 0, "alignment");
constexpr int CW_BAR = 4096;
constexpr int RING_OFF = 0, RING_BYTES = 131072;
constexpr int LDSCTL_OFF = RING_BYTES, MISC_OFF = LDSCTL_OFF + 320;
constexpr int LDS_BYTES = 147456;

#define GAS __attribute__((address_space(1)))
#define LAS __attribute__((address_space(3)))
typedef unsigned short bf16;
typedef unsigned v4u __attribute__((ext_vector_type(4)));
typedef unsigned v2u __attribute__((ext_vector_type(2)));
typedef float f32x4 __attribute__((ext_vector_type(4)));
typedef short bf16x8 __attribute__((ext_vector_type(8)));
typedef GAS unsigned gu32;
#define LDS_WAIT() asm volatile("s_waitcnt lgkmcnt(0)" ::: "memory")
#define VM_WAIT() asm volatile("s_waitcnt vmcnt(0)" ::: "memory")
__device__ __forceinline__ unsigned f2bf(float f) { unsigned u = __builtin_bit_cast(unsigned, f); return (u + 0x7fffu + ((u >> 16) & 1u)) >> 16; }
__device__ __forceinline__ unsigned pk2(float lo, float hi) { return f2bf(lo) | (f2bf(hi) << 16); }
__device__ __forceinline__ float bf2f(unsigned short b) { return __builtin_bit_cast(float, (unsigned)b << 16); }
__device__ __forceinline__ float bflo(unsigned w) { return __builtin_bit_cast(float, w << 16); }
__device__ __forceinline__ float bfhi(unsigned w) { return __builtin_bit_cast(float, w & 0xffff0000u); }
__device__ __forceinline__ float wave_sum(float v) {
#pragma unroll
    for (int o = 1; o < 64; o <<= 1) v += __shfl_xor(v, o);
    return v;
}
using pg8::gelu_tanh_f; using pg8::sigmoid_f;

#define XB_TMO      128
#define XB_XCNT(j)  (256  + 64 * (j))
#define XB_XSUB(j)  (1280 + 64 * (j))
#define XB_XGEN(j)  (2304 + 64 * (j))
#define XB_TOP      3328
#define XB_TOPGEN   3392
#define XCD_BAR_WORDS 3456
#define XB_SPIN_CAP (1u << 18)

__device__ __forceinline__ unsigned xb_ld(unsigned* p)              { return __hip_atomic_load(p, __ATOMIC_RELAXED, __HIP_MEMORY_SCOPE_AGENT); }
__device__ __forceinline__ unsigned xb_add(unsigned* p, unsigned v) { return __hip_atomic_fetch_add(p, v, __ATOMIC_RELAXED, __HIP_MEMORY_SCOPE_AGENT); }
__device__ __forceinline__ unsigned xb_xcc_id() { return (unsigned)__builtin_amdgcn_s_getreg((3 << 11) | 20) & 0xFu; }
#define XB_SPIN(cond, bar) do { unsigned _sp = 0; while (cond) { __builtin_amdgcn_s_sleep(1); \
    if ((++_sp & 255u) == 0u) { if (xb_ld(&(bar)[XB_TMO])) break; if (_sp > XB_SPIN_CAP) { atomicAdd(&(bar)[XB_TMO], 1u); break; } } } } while (0)

struct XcdBarrier {
    unsigned* bar; unsigned x;
    volatile LAS unsigned* st;
};

__device__ __forceinline__ XcdBarrier xcd_barrier_post(unsigned* bar, volatile LAS unsigned* st) {
    XcdBarrier b; b.bar = bar; b.x = xb_xcc_id(); b.st = st;
    if (threadIdx.x == 0) (void)xb_add(&bar[XB_XCNT(b.x)], 1u);
    return b;
}
__device__ __forceinline__ void xcd_barrier_complete(unsigned* bar, unsigned x, unsigned& nloc, unsigned& nx) {
    const unsigned G = gridDim.x * gridDim.y * gridDim.z;
    unsigned sum, cnt, mine, sp = 0u;
    for (;;) {
        sum = 0u; cnt = 0u; mine = 0u;
#pragma unroll
        for (unsigned j = 0; j < 16; ++j) { const unsigned c = xb_ld(&bar[XB_XCNT(j)]); sum += c; cnt += (c > 0u) ? 1u : 0u; mine = (j == x) ? c : mine; }
        if (sum == G) break;
        __builtin_amdgcn_s_sleep(1);
        if ((++sp & 255u) == 0u) { if (xb_ld(&bar[XB_TMO])) break; if (sp > XB_SPIN_CAP) { atomicAdd(&bar[XB_TMO], 1u); break; } }
    }
    nloc = mine > 0u ? mine : 1u; nx = cnt > 0u ? cnt : 1u;
}

__device__ __forceinline__ void xcd_barrier(const XcdBarrier& b) {
    asm volatile("s_waitcnt vmcnt(0)" ::: "memory");
    __syncthreads();
    if (threadIdx.x == 0) {
        unsigned* bar = b.bar;
        __builtin_amdgcn_s_waitcnt(0);
        unsigned nloc = b.st[0], nx = b.st[1];
        if (nloc == 0u) { xcd_barrier_complete(bar, b.x, nloc, nx); b.st[0] = nloc; b.st[1] = nx; }
        const unsigned old = xb_add(&bar[XB_XSUB(b.x)], 1u);
        const unsigned gen = old / nloc;
        if (old + 1u == (gen + 1u) * nloc) {
            __builtin_amdgcn_fence(__ATOMIC_RELEASE, "agent");
            asm volatile("s_waitcnt vmcnt(0)" ::: "memory");
            const unsigned og = xb_add(&bar[XB_TOP], 1u);
            const unsigned tg = og / nx;
            if (og + 1u == (tg + 1u) * nx) xb_add(&bar[XB_TOPGEN], 1u);
            else XB_SPIN(xb_ld(&bar[XB_TOPGEN]) == tg, bar);
            __builtin_amdgcn_fence(__ATOMIC_ACQUIRE, "agent");
            xb_add(&bar[XB_XGEN(b.x)], 1u);
            asm volatile("s_waitcnt vmcnt(0)" ::: "memory");
        } else {
            XB_SPIN(xb_ld(&bar[XB_XGEN(b.x)]) == gen, bar);
            __builtin_amdgcn_fence(__ATOMIC_ACQUIRE, "agent");
            asm volatile("s_waitcnt vmcnt(0)" ::: "memory");
        }
    }
    __syncthreads();
}

struct Args { const float* in[28]; float* out; unsigned char* ws; int ph_lo, ph_hi; };
enum { I_XP = 0, I_XS, I_LH, I_LC, I_SRE, I_SIM, I_META, I_GAIN, I_LWIN, I_LWCONV, I_LBCONV, I_LWA, I_LBA, I_LWX, I_LBX, I_LLAM, I_LWOUT,
       I_SLRE, I_SLIM, I_SLDT, I_SBRE, I_SBIM, I_SCRE, I_SCIM, I_SD, I_SWOUT, I_FWIN, I_FWOUT };

struct Ctx {
    LAS unsigned char* lds;
    int tid, lane, wave, vcu, G;
    const float* const* in; float* out; unsigned char* ws;
};

__device__ __forceinline__ void transpose_item(const float* W, int K, int N, bf16* WT, int half, const float* gain, LAS float* scr, int item, int lane) {
    const int nblk = N / 32, kb = item / nblk, nb = item % nblk, k0 = 64 * kb, n0 = 32 * nb;
    int r0 = n0;
    if (half) { const int c = n0 < half ? n0 : n0 - half; r0 = 256 * (c >> 7) + (c & 127) + (n0 < half ? 0 : 128); }
    f32x4 v[8];
#pragma unroll
    for (int i = 0; i < 8; ++i) { const int kk = 8 * i + (lane >> 3); v[i] = *(const GAS f32x4*)(W + (size_t)(k0 + kk) * N + n0 + 4 * (lane & 7)); }
#pragma unroll
    for (int i = 0; i < 8; ++i) { const int kk = 8 * i + (lane >> 3); const float gk = gain ? gain[k0 + kk] : 1.0f; LAS float* d = scr + kk * 33 + 4 * (lane & 7);
        d[0] = v[i].x * gk; d[1] = v[i].y * gk; d[2] = v[i].z * gk; d[3] = v[i].w * gk; }
    LDS_WAIT(); asm volatile("" ::: "memory");
    const int c = lane & 7;
#pragma unroll
    for (int j = 0; j < 4; ++j) { const int n = (lane >> 3) + 8 * j; const LAS float* s = scr + (8 * c) * 33 + n;
        v4u o; o.x = pk2(s[0 * 33], s[1 * 33]); o.y = pk2(s[2 * 33], s[3 * 33]); o.z = pk2(s[4 * 33], s[5 * 33]); o.w = pk2(s[6 * 33], s[7 * 33]);
        *(GAS v4u*)(WT + (size_t)(r0 + n) * K + k0 + 8 * c) = o; }
    LDS_WAIT(); asm volatile("" ::: "memory");
}
__device__ __forceinline__ const float* x0_row(const Ctx& C, int r) {
    if (r < R_META) return C.in[I_XP] + (size_t)r * D;
    if (r < R_SMP) return C.in[I_META] + (size_t)(r - R_META) * D;
    return C.in[I_XS] + (size_t)(r - R_SMP) * D;
}
__device__ __forceinline__ float* xs_row(const Ctx& C, int r) {
    if (r < R_META) return C.out + O_YP + (size_t)r * D;
    return (float*)(C.ws + WS_XEX) + (size_t)(r - R_META) * D;
}
__device__ __forceinline__ float sin2pi(float turns) { return __builtin_amdgcn_sinf(turns - rintf(turns)); }
__device__ __forceinline__ float cos2pi(float turns) { return __builtin_amdgcn_cosf(turns - rintf(turns)); }

__device__ __forceinline__ void s5_prep_group(const Ctx& C, int g) {
    LAS float* PWr = (LAS float*)(C.lds + RING_OFF);
    LAS float* PWi = PWr + 17 * 64;
    LAS float* BBr = PWi + 17 * 64;
    LAS float* BBi = BBr + 1024;
    LAS float* Cr = BBi + 1024;
    LAS float* Ci = Cr + 1024;
    LAS float* KT = Ci + 1024;
    const int tid = C.tid;
    const float INV2PI = 0.15915494309189535f;
    if (tid < 64) {
        const int p = tid;
        const float dt = expf(C.in[I_SLDT][g]);
        const float lr = C.in[I_SLRE][g * 64 + p], li = C.in[I_SLIM][g * 64 + p];
        const float x = dt * lr, y = dt * li, yt = y * INV2PI;
        for (int tau = 0; tau <= 16; ++tau) { const float mag = expf((float)tau * x), tr = (float)tau * yt;
            PWr[tau * 64 + p] = mag * cos2pi(tr); PWi[tau * 64 + p] = mag * sin2pi(tr); }
        const float em1 = expm1f(x), cy = cos2pi(yt), sy = sin2pi(yt), sh = sin2pi(0.5f * yt), cm1 = -2.0f * sh * sh;
        const float ar = em1 * cy + cm1, ai = (em1 + 1.0f) * sy;
        const float den = 1.0f / (lr * lr + li * li);
        const float qr = (ar * lr + ai * li) * den, qi = (ai * lr - ar * li) * den;
        for (int c = 0; c < 16; ++c) { const float br = C.in[I_SBRE][(size_t)(g * 64 + p) * 16 + c], bi = C.in[I_SBIM][(size_t)(g * 64 + p) * 16 + c];
            BBr[p * 16 + c] = qr * br - qi * bi; BBi[p * 16 + c] = qr * bi + qi * br; }
        float* S5C = (float*)(C.ws + WS_S5C);
        S5C[0 * 4096 + g * 64 + p] = PWr[16 * 64 + p]; S5C[1 * 4096 + g * 64 + p] = PWi[16 * 64 + p];
        S5C[2 * 4096 + g * 64 + p] = PWr[1 * 64 + p];  S5C[3 * 4096 + g * 64 + p] = PWi[1 * 64 + p];
        const float mag = expf(-15.0f * x), tr = -15.0f * yt;
        S5C[4 * 4096 + g * 64 + p] = mag * cos2pi(tr); S5C[5 * 4096 + g * 64 + p] = mag * sin2pi(tr);
    }
    for (int i = tid; i < 1024; i += 512) { Cr[i] = C.in[I_SCRE][(size_t)g * 1024 + i]; Ci[i] = C.in[I_SCIM][(size_t)g * 1024 + i]; }
    __syncthreads();
    for (int e = tid; e < 4096; e += 512) { const int tau = e >> 8, co = (e >> 4) & 15, ci = e & 15; float acc = 0.f;
        for (int p = 0; p < 64; ++p) { const float pr = PWr[tau * 64 + p], pi = PWi[tau * 64 + p], br = BBr[p * 16 + ci], bi = BBi[p * 16 + ci];
            const float tr = pr * br - pi * bi, ti = pr * bi + pi * br; acc += Cr[co * 64 + p] * tr - Ci[co * 64 + p] * ti; }
        KT[e] = acc; }
    __syncthreads();
    bf16* WY = (bf16*)(C.ws + WS_S5WY) + (size_t)g * 256 * 384;
    for (int e = tid; e < 256 * 48; e += 512) { const int n = e / 48, kg = e % 48, t = n >> 4, co = n & 15; float v[8];
#pragma unroll
        for (int q = 0; q < 8; ++q) { const int k = kg * 8 + q; float val;
            if (k < 256) { const int s = k >> 4, ci = k & 15; val = (s <= t) ? KT[(t - s) * 256 + co * 16 + ci] : 0.f; }
            else if (k < 320) { const int p = k - 256; val = Cr[co * 64 + p] * PWr[(t + 1) * 64 + p] - Ci[co * 64 + p] * PWi[(t + 1) * 64 + p]; }
            else { const int p = k - 320; val = -(Cr[co * 64 + p] * PWi[(t + 1) * 64 + p] + Ci[co * 64 + p] * PWr[(t + 1) * 64 + p]); }
            v[q] = val; }
        v4u o; o.x = pk2(v[0], v[1]); o.y = pk2(v[2], v[3]); o.z = pk2(v[4], v[5]); o.w = pk2(v[6], v[7]);
        *(GAS v4u*)(WY + (size_t)n * 384 + kg * 8) = o; }
    bf16* WE = (bf16*)(C.ws + WS_S5WE) + (size_t)g * 128 * 256;
    for (int e = tid; e < 128 * 32; e += 512) { const int n = e >> 5, kg = e & 31, p = n & 63, im = n >> 6; float v[8];
#pragma unroll
        for (int q = 0; q < 8; ++q) { const int k = kg * 8 + q, s = k >> 4, ci = k & 15;
            const float pr = PWr[(15 - s) * 64 + p], pi = PWi[(15 - s) * 64 + p], br = BBr[p * 16 + ci], bi = BBi[p * 16 + ci];
            v[q] = im ? (pr * bi + pi * br) : (pr * br - pi * bi); }
        v4u o; o.x = pk2(v[0], v[1]); o.y = pk2(v[2], v[3]); o.z = pk2(v[4], v[5]); o.w = pk2(v[6], v[7]);
        *(GAS v4u*)(WE + (size_t)n * 256 + kg * 8) = o; }
    __syncthreads();
}

__device__ __forceinline__ void p0_prologue(const Ctx& C) {
    __syncthreads();
    if (C.vcu < 64) s5_prep_group(C, C.vcu);
    LAS float* scr = (LAS float*)(C.lds + RING_OFF + C.wave * 16384);
    const int gw = C.vcu * NWAVES + C.wave, NGW = C.G * NWAVES;
    constexpr int I_1 = (1024 / 64) * (2816 / 32), I_2 = (1408 / 64) * (1024 / 32), I_3 = (1024 / 64) * (5632 / 32), I_4 = (2816 / 64) * (1024 / 32), I_5 = (1024 / 64) * (2048 / 32);
    constexpr int NITEMS = I_1 + I_2 + 2 * I_3 + 2 * I_4 + I_5;
    for (int it = gw; it < NITEMS; it += NGW) {
        int r = it;
        if (r < I_1) { transpose_item(C.in[I_LWIN], 1024, 2816, (bf16*)(C.ws + WS_W1T), 0, C.in[I_GAIN] + 0 * D, scr, r, C.lane); continue; } r -= I_1;
        if (r < I_2) { transpose_item(C.in[I_LWOUT], 1408, 1024, (bf16*)(C.ws + WS_W2T), 0, nullptr, scr, r, C.lane); continue; } r -= I_2;
        if (r < I_3) { transpose_item(C.in[I_FWIN], 1024, 5632, (bf16*)(C.ws + WS_W3T), 2816, C.in[I_GAIN] + 2 * D, scr, r, C.lane); continue; } r -= I_3;
        if (r < I_3) { transpose_item(C.in[I_FWIN] + (size_t)1024 * 5632, 1024, 5632, (bf16*)(C.ws + WS_W3T) + (size_t)5632 * 1024, 2816, C.in[I_GAIN] + 6 * D, scr, r, C.lane); continue; } r -= I_3;
        if (r < I_4) { transpose_item(C.in[I_FWOUT], 2816, 1024, (bf16*)(C.ws + WS_W4T), 0, nullptr, scr, r, C.lane); continue; } r -= I_4;
        if (r < I_4) { transpose_item(C.in[I_FWOUT] + (size_t)2816 * 1024, 2816, 1024, (bf16*)(C.ws + WS_W4T) + (size_t)1024 * 2816, 0, nullptr, scr, r, C.lane); continue; } r -= I_4;
        transpose_item(C.in[I_SWOUT], 1024, 2048, (bf16*)(C.ws + WS_W5T), 1024, nullptr, scr, r, C.lane);
    }
    { bf16* WG = (bf16*)(C.ws + WS_WGT); const int gt = (C.vcu * NWAVES + C.wave) * 64 + C.lane, NT = C.G * 512;
      for (int e = gt; e < 16 * 2 * 96 * 96; e += NT) { const int i = e % 96, j = (e / 96) % 96, gate = (e / 9216) & 1, h = e / 18432;
          const float* wsel = gate ? C.in[I_LWX] : C.in[I_LWA]; float v = 0.f; if (i < 88 && j < 88) v = wsel[(size_t)(h * 88 + i) * 88 + j];
          WG[e] = (bf16)f2bf(v); } }
    { bf16* X = (bf16*)(C.ws + WS_XN); float* RSTD = (float*)(C.ws + WS_XEX);
      for (int r = gw; r < R_END; r += NGW) {
          const GAS f32x4* xr = (const GAS f32x4*)x0_row(C, r) + C.lane; f32x4 v[4]; float s = 0.f;
#pragma unroll
          for (int j = 0; j < 4; ++j) { v[j] = xr[64 * j]; s += (v[j].x * v[j].x + v[j].y * v[j].y) + (v[j].z * v[j].z + v[j].w * v[j].w); }
          const float rs = rsqrtf(wave_sum(s) * (1.f / D) + RMS_EPS);
          if (C.lane == 0) RSTD[r] = rs;
          GAS v2u* o8 = (GAS v2u*)(X + (size_t)r * D) + C.lane;
#pragma unroll
          for (int j = 0; j < 4; ++j) { v2u o; o.x = pk2(v[j].x, v[j].y); o.y = pk2(v[j].z, v[j].w); o8[64 * j] = o; } }
      if (gw == 0) for (int r = R_END + C.lane; r < MROWS; r += 64) RSTD[r] = 0.f; }
}

template <int MODE>
__device__ __forceinline__ void nr_phase(const Ctx& C, const bf16* MB, const float* ga, const float* gb, int nslab, int ldn, bool glu, int r_lo) {
    const float* slab = (const float*)(C.ws + WS_SLAB);
    const int gw = C.vcu * NWAVES + C.wave, NGW = C.G * NWAVES, lane = C.lane;
    bf16* X = (bf16*)(C.ws + WS_XN); bf16* XNS = (bf16*)(C.ws + WS_R1); float* RSTD = (float*)(C.ws + WS_XEX);
    for (int r = r_lo + gw; r < R_END; r += NGW) {
        if (MODE == 3 && r >= R_META && r < R_SMP) continue;
        const GAS v2u* mr = (const GAS v2u*)(MB + (size_t)r * D) + lane;
        GAS v2u* xr = (GAS v2u*)(X + (size_t)r * D) + lane;
        f32x4 m[4], x[4]; float s = 0.f;
#pragma unroll
        for (int j = 0; j < 4; ++j) {
            if (r < R_META) { const v2u w = mr[64 * j]; m[j] = (f32x4){bflo(w.x), bfhi(w.x), bflo(w.y), bfhi(w.y)}; }
            else {
                const int er = r - R_META; f32x4 a0 = {0.f, 0.f, 0.f, 0.f}, a1 = {0.f, 0.f, 0.f, 0.f};
                const int cz = glu ? 256 * (2 * j + (lane >> 5)) + 4 * (lane & 31) : 256 * j + 4 * lane;
                for (int sidx = 0; sidx < nslab; ++sidx) { const float* sp = slab + ((size_t)sidx * 144 + er) * ldn + cz;
                    a0 = a0 + *(const GAS f32x4*)sp; if (glu) a1 = a1 + *(const GAS f32x4*)(sp + 128); }
                if (glu) { a0.x *= sigmoid_f(a1.x); a0.y *= sigmoid_f(a1.y); a0.z *= sigmoid_f(a1.z); a0.w *= sigmoid_f(a1.w); }
                m[j] = a0; }
            const v2u xw = xr[64 * j]; x[j] = (f32x4){bflo(xw.x), bfhi(xw.x), bflo(xw.y), bfhi(xw.y)};
            s += (m[j].x * m[j].x + m[j].y * m[j].y) + (m[j].z * m[j].z + m[j].w * m[j].w); }
        const float rs = rsqrtf(wave_sum(s) * (1.f / D) + RMS_EPS);
        float s2 = 0.f;
#pragma unroll
        for (int j = 0; j < 4; ++j) { const f32x4 gg = *((const GAS f32x4*)ga + lane + 64 * j);
            x[j] = x[j] + m[j] * rs * gg; s2 += (x[j].x * x[j].x + x[j].y * x[j].y) + (x[j].z * x[j].z + x[j].w * x[j].w); }
        if (MODE == 3) {
            float* yd = (r < R_META) ? C.out + O_YP + (size_t)r * D : C.out + O_YS + (size_t)(r - R_SMP) * D;
#pragma unroll
            for (int j = 0; j < 4; ++j) *((GAS f32x4*)yd + lane + 64 * j) = x[j];
            continue; }
#pragma unroll
        for (int j = 0; j < 4; ++j) { v2u o; o.x = pk2(x[j].x, x[j].y); o.y = pk2(x[j].z, x[j].w); xr[64 * j] = o; }
        const float rs2 = rsqrtf(wave_sum(s2) * (1.f / D) + RMS_EPS);
        if (lane == 0) RSTD[r] = rs2;
        if (MODE == 1) {
            v2u o[4];
#pragma unroll
            for (int j = 0; j < 4; ++j) { const f32x4 gg = *((const GAS f32x4*)gb + lane + 64 * j);
                o[j].x = pk2(x[j].x * rs2 * gg.x, x[j].y * rs2 * gg.y); o[j].y = pk2(x[j].z * rs2 * gg.z, x[j].w * rs2 * gg.w); }
            if (r < R_META) { const int b = r >> 11, jt = r & 2047, rb = b * 129 + 1 + (jt >> 4), s = jt & 15;
#pragma unroll
                for (int j = 0; j < 4; ++j) *(GAS v2u*)(XNS + (((size_t)rb * 64 + 16 * j + (lane >> 2)) * 16 + s) * 16 + 4 * (lane & 3)) = o[j]; }
            else if (r < R_SMP) { const int s = r - R_META;
                for (int b = 0; b < NBATCH; ++b)
#pragma unroll
                    for (int j = 0; j < 4; ++j) *(GAS v2u*)(XNS + (((size_t)(b * 129) * 64 + 16 * j + (lane >> 2)) * 16 + s) * 16 + 4 * (lane & 3)) = o[j]; }
            else { const int rb = 1032 + (r - R_SMP);
#pragma unroll
                for (int j = 0; j < 4; ++j) *(GAS v2u*)(XNS + (((size_t)rb * 64 + 16 * j + (lane >> 2)) * 16 + 0) * 16 + 4 * (lane & 3)) = o[j];
                GAS v2u* zb = (GAS v2u*)(XNS + (size_t)rb * 64 * 256);
                for (int e = lane; e < 64 * 60; e += 64) { const int g = e / 60, q = e % 60; zb[g * 64 + 4 + q] = (v2u){0u, 0u}; } }
        }
    }
}

constexpr int L2_XB = 0, L2_XCA = 23552, L2_XCF = 50176, L2_AGG = 101376, L2_CW = 107520;
typedef float f32x2 __attribute__((ext_vector_type(2)));

__device__ __forceinline__ void lru2_block(const Ctx& C) {
    const int b = C.vcu >> 5, h = (C.vcu >> 1) & 15, half = C.vcu & 1;
    const int tid = C.tid, lane = C.lane, w = C.wave, fr = lane & 15, fq = lane >> 4, ch0 = 88 * h;
    LAS bf16* XB = (LAS bf16*)(C.lds + RING_OFF + L2_XB); LAS bf16* XCA = (LAS bf16*)(C.lds + RING_OFF + L2_XCA); LAS float* XCF = (LAS float*)(C.lds + RING_OFF + L2_XCF);
    LAS f32x2* AGG = (LAS f32x2*)(C.lds + RING_OFF + L2_AGG); LAS float* CW = (LAS float*)(C.lds + RING_OFF + L2_CW);
    const bf16* XG = (const bf16*)(C.ws + WS_R1); bf16* A2 = (bf16*)(C.ws + WS_R2);
    float ba[3], bx[3], c1[3]; int chg[3], cll[3]; bool valid[3]; bf16x8 bA[3][3], bX[3][3];
    { const bf16* WG = (const bf16*)(C.ws + WS_WGT);
#pragma unroll
      for (int nt = 0; nt < 3; ++nt) { const int cl = 48 * half + 16 * nt + fr; valid[nt] = cl < 88; cll[nt] = cl < 88 ? cl : 87; chg[nt] = ch0 + cll[nt];
          ba[nt] = C.in[I_LBA][chg[nt]]; bx[nt] = C.in[I_LBX][chg[nt]]; c1[nt] = -8.0f * 1.442695041f * log1pf(expf(-C.in[I_LLAM][chg[nt]]));
#pragma unroll
          for (int ks = 0; ks < 3; ++ks) { bA[nt][ks] = *(const GAS bf16x8*)(WG + ((size_t)(h * 2 + 0) * 96 + cl) * 96 + ks * 32 + fq * 8);
              bX[nt][ks] = *(const GAS bf16x8*)(WG + ((size_t)(h * 2 + 1) * 96 + cl) * 96 + ks * 32 + fq * 8); } } }
    __syncthreads();
    for (int e = tid; e < 5 * 96; e += 512) { const int k = e / 96, i = e % 96; float v = 0.f;
        if (i < 88) v = (k < 4) ? C.in[I_LWCONV][k * DR + ch0 + i] : C.in[I_LBCONV][ch0 + i];
        CW[e] = v; }
    for (int e = tid; e < 128 * 16; e += 512) XCA[(e >> 4) * 104 + 88 + (e & 15)] = 0;
#define LRU_ROW(t) (((t) < NMETA) ? (size_t)(R_META + (t)) : (size_t)b * SEQ + (size_t)((t) - NMETA))
#define LRU_LOAD(c, pf) do { _Pragma("unroll") for (int q = 0; q < 3; ++q) { const int e = tid + 512 * q; (pf)[q] = (v4u){0u, 0u, 0u, 0u}; \
        if (e < 131 * 11) { const int rr = e / 11, pc = e % 11, t = 128 * (c) - 3 + rr; if (t >= 0 && t < NMETA + SEQ) (pf)[q] = *(const GAS v4u*)(XG + LRU_ROW(t) * 2816 + ch0 + pc * 8); } } } while (0)
#define LRU_PUT(pf) do { _Pragma("unroll") for (int q = 0; q < 3; ++q) { const int e = tid + 512 * q; if (e < 131 * 11) { const int rr = e / 11, pc = e % 11; *(LAS v4u*)(XB + rr * 88 + pc * 8) = (pf)[q]; } } } while (0)
    { v4u pf[3]; LRU_LOAD(0, pf); LRU_PUT(pf); }
    __syncthreads();
    float hc[3] = {0.f, 0.f, 0.f};
    for (int c = 0; c < 17; ++c) {
        const int nvw = (c < 16) ? 8 : 1;
        v4u pf[3];
        if (c < 16) LRU_LOAD(c + 1, pf);
#pragma unroll
        for (int q = 0; q < 3; ++q) { const int e = tid + 512 * q;
            if (e < 11 * 128) { const int pc = e >> 7, tl = e & 127; float acc[8];
                { const f32x4 b0 = *(const LAS f32x4*)(CW + 4 * 96 + pc * 8), b1 = *(const LAS f32x4*)(CW + 4 * 96 + pc * 8 + 4);
                  acc[0] = b0.x; acc[1] = b0.y; acc[2] = b0.z; acc[3] = b0.w; acc[4] = b1.x; acc[5] = b1.y; acc[6] = b1.z; acc[7] = b1.w; }
#pragma unroll
                for (int k = 0; k < 4; ++k) { const v4u xv = *(const LAS v4u*)(XB + (tl + k) * 88 + pc * 8);
                    const f32x4 w0 = *(const LAS f32x4*)(CW + k * 96 + pc * 8), w1 = *(const LAS f32x4*)(CW + k * 96 + pc * 8 + 4);
                    acc[0] += w0.x * bflo(xv.x); acc[1] += w0.y * bfhi(xv.x); acc[2] += w0.z * bflo(xv.y); acc[3] += w0.w * bfhi(xv.y);
                    acc[4] += w1.x * bflo(xv.z); acc[5] += w1.y * bfhi(xv.z); acc[6] += w1.z * bflo(xv.w); acc[7] += w1.w * bfhi(xv.w); }
                v4u o; o.x = pk2(acc[0], acc[1]); o.y = pk2(acc[2], acc[3]); o.z = pk2(acc[4], acc[5]); o.w = pk2(acc[6], acc[7]);
                *(LAS v4u*)(XCA + tl * 104 + pc * 8) = o;
                *(LAS f32x4*)(XCF + tl * 100 + pc * 8) = (f32x4){acc[0], acc[1], acc[2], acc[3]}; *(LAS f32x4*)(XCF + tl * 100 + pc * 8 + 4) = (f32x4){acc[4], acc[5], acc[6], acc[7]}; } }
        __syncthreads();
        float A_[3][4], B_[3][4], cA[3], cB[3], gg[3][4];
        {
            bf16x8 a[3];
#pragma unroll
            for (int ks = 0; ks < 3; ++ks) a[ks] = *(const LAS bf16x8*)(XCA + (16 * w + fr) * 104 + ks * 32 + fq * 8);
#pragma unroll
            for (int nt = 0; nt < 3; ++nt) {
                if (w < nvw) {
#pragma unroll
                    for (int j = 0; j < 4; ++j) { const int t = 128 * c + 16 * w + 4 * fq + j; gg[nt][j] = bf2f(XG[LRU_ROW(t) * 2816 + DR + chg[nt]]); } }
                f32x4 accR = {0.f, 0.f, 0.f, 0.f}, accI = {0.f, 0.f, 0.f, 0.f};
#pragma unroll
                for (int ks = 0; ks < 3; ++ks) { accR = __builtin_amdgcn_mfma_f32_16x16x32_bf16(a[ks], bA[nt][ks], accR, 0, 0, 0);
                    accI = __builtin_amdgcn_mfma_f32_16x16x32_bf16(a[ks], bX[nt][ks], accI, 0, 0, 0); }
                float av[4], bv[4];
#pragma unroll
                for (int j = 0; j < 4; ++j) { const float xc = XCF[(16 * w + 4 * fq + j) * 100 + cll[nt]];
                    const float r = sigmoid_f(accR[j] + ba[nt]), ig = sigmoid_f(accI[j] + bx[nt]);
                    const float aa = __builtin_amdgcn_exp2f(c1[nt] * r);
                    const float om = __builtin_fmaf(-aa, aa, 1.0f);
                    av[j] = aa; bv[j] = __builtin_amdgcn_sqrtf(om > 0.f ? om : 0.f) * (ig * xc); }
                A_[nt][0] = av[0]; B_[nt][0] = bv[0];
#pragma unroll
                for (int j = 1; j < 4; ++j) { A_[nt][j] = av[j] * A_[nt][j - 1]; B_[nt][j] = av[j] * B_[nt][j - 1] + bv[j]; }
                const float tA = A_[nt][3], tB = B_[nt][3];
                const float gA0 = __shfl(tA, fr), gB0 = __shfl(tB, fr), gA1 = __shfl(tA, fr + 16), gB1 = __shfl(tB, fr + 16);
                const float gA2 = __shfl(tA, fr + 32), gB2 = __shfl(tB, fr + 32), gA3 = __shfl(tA, fr + 48), gB3 = __shfl(tB, fr + 48);
                const float c2A = gA1 * gA0, c2B = gA1 * gB0 + gB1, c3A = gA2 * c2A, c3B = gA2 * c2B + gB2;
                float tilA = gA3 * c3A, tilB = gA3 * c3B + gB3;
                cA[nt] = fq == 0 ? 1.f : (fq == 1 ? gA0 : (fq == 2 ? c2A : c3A)); cB[nt] = fq == 0 ? 0.f : (fq == 1 ? gB0 : (fq == 2 ? c2B : c3B));
                if (w >= nvw) { tilA = 1.f; tilB = 0.f; }
                if (fq == 0) AGG[((c & 1) * 8 + w) * 48 + nt * 16 + fr] = (f32x2){tilA, tilB};
            }
        }
        __syncthreads();
#pragma unroll
        for (int nt = 0; nt < 3; ++nt) { float hcur = hc[nt], hst = hc[nt];
#pragma unroll
            for (int ww = 0; ww < 8; ++ww) { const f32x2 ag = AGG[((c & 1) * 8 + ww) * 48 + nt * 16 + fr]; if (ww == w) hst = hcur; hcur = ag.y + ag.x * hcur; }
            hc[nt] = hcur;
            if (w < nvw) { const float hb = cB[nt] + cA[nt] * hst;
#pragma unroll
                for (int j = 0; j < 4; ++j) { const float hj = B_[nt][j] + A_[nt][j] * hb; const int t = 128 * c + 16 * w + 4 * fq + j;
                    if (valid[nt] && (b == 0 || t >= NMETA)) A2[LRU_ROW(t) * DR + chg[nt]] = (bf16)f2bf(hj * gg[nt][j]); } } }
        if (c < 16) LRU_PUT(pf);
        __syncthreads();
    }
    if (w == 0 && fq == 0) {
#pragma unroll
        for (int nt = 0; nt < 3; ++nt) if (valid[nt]) C.out[O_LHP + (size_t)b * DR + chg[nt]] = hc[nt]; }
    if (tid < 3 * 48) { const int k = tid / 48, cl = 48 * half + tid % 48;
        if (cl < 88) C.out[O_LCP + ((size_t)b * 3 + k) * DR + ch0 + cl] = bf2f(XG[((size_t)b * SEQ + (SEQ - 3 + k)) * 2816 + ch0 + cl]); }
    if (b == 0) {
        const float* cs = C.in[I_LC]; const float* h0 = C.in[I_LH];
#pragma unroll
        for (int q = 0; q < 3; ++q) { const int e = tid + 512 * q;
            if (e < 11 * 128) { const int pc = e >> 7, i = e & 127, c8 = ch0 + pc * 8; float acc[8], xs[4][8];
                { const v4u xv = *(const GAS v4u*)(XG + (size_t)(R_SMP + i) * 2816 + c8);
                  xs[3][0] = bflo(xv.x); xs[3][1] = bfhi(xv.x); xs[3][2] = bflo(xv.y); xs[3][3] = bfhi(xv.y); xs[3][4] = bflo(xv.z); xs[3][5] = bfhi(xv.z); xs[3][6] = bflo(xv.w); xs[3][7] = bfhi(xv.w); }
#pragma unroll
                for (int k = 0; k < 3; ++k) { const f32x4 s0 = *(const GAS f32x4*)(cs + ((size_t)i * 3 + k) * DR + c8), s1 = *(const GAS f32x4*)(cs + ((size_t)i * 3 + k) * DR + c8 + 4);
                    xs[k][0] = s0.x; xs[k][1] = s0.y; xs[k][2] = s0.z; xs[k][3] = s0.w; xs[k][4] = s1.x; xs[k][5] = s1.y; xs[k][6] = s1.z; xs[k][7] = s1.w; }
#pragma unroll
                for (int u = 0; u < 8; ++u) { acc[u] = CW[4 * 96 + pc * 8 + u];
#pragma unroll
                    for (int k = 0; k < 4; ++k) acc[u] += CW[k * 96 + pc * 8 + u] * xs[k][u]; }
                v4u o; o.x = pk2(acc[0], acc[1]); o.y = pk2(acc[2], acc[3]); o.z = pk2(acc[4], acc[5]); o.w = pk2(acc[6], acc[7]);
                *(LAS v4u*)(XCA + i * 104 + pc * 8) = o;
                *(LAS f32x4*)(XCF + i * 100 + pc * 8) = (f32x4){acc[0], acc[1], acc[2], acc[3]}; *(LAS f32x4*)(XCF + i * 100 + pc * 8 + 4) = (f32x4){acc[4], acc[5], acc[6], acc[7]};
                if (half == 0) {
#pragma unroll
                    for (int k = 0; k < 3; ++k) { float* op = C.out + O_LCS + ((size_t)i * 3 + k) * DR + c8;
                        *(GAS f32x4*)op = (f32x4){xs[k + 1][0], xs[k + 1][1], xs[k + 1][2], xs[k + 1][3]}; *(GAS f32x4*)(op + 4) = (f32x4){xs[k + 1][4], xs[k + 1][5], xs[k + 1][6], xs[k + 1][7]}; } } } }
        __syncthreads();
        bf16x8 a[3];
#pragma unroll
        for (int ks = 0; ks < 3; ++ks) a[ks] = *(const LAS bf16x8*)(XCA + (16 * w + fr) * 104 + ks * 32 + fq * 8);
#pragma unroll
        for (int nt = 0; nt < 3; ++nt) {
            f32x4 accR = {0.f, 0.f, 0.f, 0.f}, accI = {0.f, 0.f, 0.f, 0.f};
#pragma unroll
            for (int ks = 0; ks < 3; ++ks) { accR = __builtin_amdgcn_mfma_f32_16x16x32_bf16(a[ks], bA[nt][ks], accR, 0, 0, 0);
                accI = __builtin_amdgcn_mfma_f32_16x16x32_bf16(a[ks], bX[nt][ks], accI, 0, 0, 0); }
#pragma unroll
            for (int j = 0; j < 4; ++j) { const int i = 16 * w + 4 * fq + j; const float xc = XCF[i * 100 + cll[nt]];
                const float r = sigmoid_f(accR[j] + ba[nt]), ig = sigmoid_f(accI[j] + bx[nt]);
                const float aa = __builtin_amdgcn_exp2f(c1[nt] * r);
                const float om = __builtin_fmaf(-aa, aa, 1.0f);
                const float bb = __builtin_amdgcn_sqrtf(om > 0.f ? om : 0.f) * (ig * xc);
                const float hn = aa * h0[(size_t)i * DR + chg[nt]] + bb;
                const float g1 = bf2f(XG[(size_t)(R_SMP + i) * 2816 + DR + chg[nt]]);
                if (valid[nt]) { A2[(size_t)(R_SMP + i) * DR + chg[nt]] = (bf16)f2bf(hn * g1); C.out[O_LHS + (size_t)i * DR + chg[nt]] = hn; } }
        }
    }
#undef LRU_ROW
#undef LRU_LOAD
#undef LRU_PUT
}

constexpr int S5_UL = 0, S5_HB = 76032;
#define CMUL_R(ar, ai, br, bi) ((ar) * (br) - (ai) * (bi))
#define CMUL_I(ar, ai, br, bi) ((ar) * (bi) + (ai) * (br))
__device__ __forceinline__ void s5_item(const Ctx& C, int it) {
    const int tid = C.tid, lane = C.lane, w = C.wave, fr = lane & 15, fq = lane >> 4;
    const bool smp = it >= 512; const int g = smp ? it - 512 : (it & 63), b = smp ? 0 : (it >> 6);
    const int rb0 = smp ? 1032 : b * 129, nrow = smp ? 128 : 129, nm = smp ? 8 : 9;
    LAS bf16* UL = (LAS bf16*)(C.lds + RING_OFF + S5_UL); LAS bf16* HB = (LAS bf16*)(C.lds + RING_OFF + S5_HB);
    const bf16* U = (const bf16*)(C.ws + WS_R1) + ((size_t)rb0 * 64 + g) * 256;
    const bf16* WE = (const bf16*)(C.ws + WS_S5WE) + (size_t)g * 128 * 256; const bf16* WY = (const bf16*)(C.ws + WS_S5WY) + (size_t)g * 256 * 384;
    const float* S5C = (const float*)(C.ws + WS_S5C); bf16* Z = (bf16*)(C.ws + WS_R2);
    __syncthreads();
    for (int e = tid; e < nrow * 32; e += 512) { const int row = e >> 5, pc = e & 31; *(LAS v4u*)(UL + row * 264 + pc * 8) = *(const GAS v4u*)(U + (size_t)row * 16384 + pc * 8); }
    __syncthreads();
    if (w < 4) {
        const int p = 16 * w + fr;
        bf16x8 bRe[8], bIm[8];
#pragma unroll
        for (int ks = 0; ks < 8; ++ks) { bRe[ks] = *(const GAS bf16x8*)(WE + (size_t)p * 256 + ks * 32 + fq * 8); bIm[ks] = *(const GAS bf16x8*)(WE + (size_t)(64 + p) * 256 + ks * 32 + fq * 8); }
        if (!smp) {
            const float q1r = S5C[0 * 4096 + g * 64 + p], q1i = S5C[1 * 4096 + g * 64 + p];
            const float q2r = CMUL_R(q1r, q1i, q1r, q1i), q2i = CMUL_I(q1r, q1i, q1r, q1i);
            const float q4r = CMUL_R(q2r, q2i, q2r, q2i), q4i = CMUL_I(q2r, q2i, q2r, q2i);
            const float q8r = CMUL_R(q4r, q4i, q4r, q4i), q8i = CMUL_I(q4r, q4i, q4r, q4i);
            const float q16r = CMUL_R(q8r, q8i, q8r, q8i), q16i = CMUL_I(q8r, q8i, q8r, q8i);
            const float q12r = CMUL_R(q4r, q4i, q8r, q8i), q12i = CMUL_I(q4r, q4i, q8r, q8i);
            const float qfr = fq == 0 ? 1.f : (fq == 1 ? q4r : (fq == 2 ? q8r : q12r)), qfi = fq == 0 ? 0.f : (fq == 1 ? q4i : (fq == 2 ? q8i : q12i));
            float Hsr = 0.f, Hsi = 0.f;
            for (int m = 0; m < 9; ++m) {
                f32x4 aR = {0.f, 0.f, 0.f, 0.f}, aI = {0.f, 0.f, 0.f, 0.f};
#pragma unroll
                for (int ks = 0; ks < 8; ++ks) { const bf16x8 a = *(const LAS bf16x8*)(UL + (16 * m + fr) * 264 + ks * 32 + fq * 8);
                    aR = __builtin_amdgcn_mfma_f32_16x16x32_bf16(a, bRe[ks], aR, 0, 0, 0); aI = __builtin_amdgcn_mfma_f32_16x16x32_bf16(a, bIm[ks], aI, 0, 0, 0); }
                float Lr = aR[0], Li = aI[0];
#pragma unroll
                for (int j = 1; j < 4; ++j) { const float nr = CMUL_R(q1r, q1i, Lr, Li) + aR[j], ni = CMUL_I(q1r, q1i, Lr, Li) + aI[j]; Lr = nr; Li = ni; }
                const float T0r = __shfl(Lr, fr), T0i = __shfl(Li, fr), T1r = __shfl(Lr, fr + 16), T1i = __shfl(Li, fr + 16);
                const float T2r = __shfl(Lr, fr + 32), T2i = __shfl(Li, fr + 32), T3r = __shfl(Lr, fr + 48), T3i = __shfl(Li, fr + 48);
                const float c2r = CMUL_R(q4r, q4i, T0r, T0i) + T1r, c2i = CMUL_I(q4r, q4i, T0r, T0i) + T1i;
                const float c3r = CMUL_R(q4r, q4i, c2r, c2i) + T2r, c3i = CMUL_I(q4r, q4i, c2r, c2i) + T2i;
                const float ttr = CMUL_R(q4r, q4i, c3r, c3i) + T3r, tti = CMUL_I(q4r, q4i, c3r, c3i) + T3i;
                const float cfr = fq == 0 ? 0.f : (fq == 1 ? T0r : (fq == 2 ? c2r : c3r)), cfi = fq == 0 ? 0.f : (fq == 1 ? T0i : (fq == 2 ? c2i : c3i));
                float sr = CMUL_R(qfr, qfi, Hsr, Hsi) + cfr, si = CMUL_I(qfr, qfi, Hsr, Hsi) + cfi;
#pragma unroll
                for (int j = 0; j < 4; ++j) { const int k = 16 * m + 4 * fq + j;
                    HB[k * 136 + p] = (bf16)f2bf(sr); HB[k * 136 + 64 + p] = (bf16)f2bf(si);
                    const float nr = CMUL_R(q1r, q1i, sr, si) + aR[j], ni = CMUL_I(q1r, q1i, sr, si) + aI[j]; sr = nr; si = ni;
                    if (m == 8 && j == 0 && fq == 0) { C.out[O_SRP + ((size_t)b * 64 + g) * 64 + p] = sr; C.out[O_SIP + ((size_t)b * 64 + g) * 64 + p] = si; } }
                const float nHr = CMUL_R(q16r, q16i, Hsr, Hsi) + ttr, nHi = CMUL_I(q16r, q16i, Hsr, Hsi) + tti; Hsr = nHr; Hsi = nHi;
            }
        } else {
            const float a1r = S5C[2 * 4096 + g * 64 + p], a1i = S5C[3 * 4096 + g * 64 + p], mr = S5C[4 * 4096 + g * 64 + p], mi = S5C[5 * 4096 + g * 64 + p];
            for (int m = 0; m < 8; ++m) {
                f32x4 aR = {0.f, 0.f, 0.f, 0.f}, aI = {0.f, 0.f, 0.f, 0.f};
#pragma unroll
                for (int ks = 0; ks < 8; ++ks) { const bf16x8 a = *(const LAS bf16x8*)(UL + (16 * m + fr) * 264 + ks * 32 + fq * 8);
                    aR = __builtin_amdgcn_mfma_f32_16x16x32_bf16(a, bRe[ks], aR, 0, 0, 0); aI = __builtin_amdgcn_mfma_f32_16x16x32_bf16(a, bIm[ks], aI, 0, 0, 0); }
#pragma unroll
                for (int j = 0; j < 4; ++j) { const int i = 16 * m + 4 * fq + j;
                    const float h0r = C.in[I_SRE][((size_t)i * 64 + g) * 64 + p], h0i = C.in[I_SIM][((size_t)i * 64 + g) * 64 + p];
                    HB[i * 136 + p] = (bf16)f2bf(h0r); HB[i * 136 + 64 + p] = (bf16)f2bf(h0i);
                    C.out[O_SRS + ((size_t)i * 64 + g) * 64 + p] = CMUL_R(a1r, a1i, h0r, h0i) + CMUL_R(mr, mi, aR[j], aI[j]);
                    C.out[O_SIS + ((size_t)i * 64 + g) * 64 + p] = CMUL_I(a1r, a1i, h0r, h0i) + CMUL_I(mr, mi, aR[j], aI[j]); }
            }
        }
    }
    __syncthreads();
    const f32x4 dsk = *(const GAS f32x4*)(C.in[I_SD] + 16 * g + 4 * fq);
    if (!smp) {
        bf16x8 bY[2][12];
#pragma unroll
        for (int nt = 0; nt < 2; ++nt)
#pragma unroll
            for (int ks = 0; ks < 12; ++ks) bY[nt][ks] = *(const GAS bf16x8*)(WY + (size_t)(16 * (2 * w + nt) + fr) * 384 + ks * 32 + fq * 8);
        for (int m = 0; m < 9; ++m) {
            f32x4 acc[2] = {{0.f, 0.f, 0.f, 0.f}, {0.f, 0.f, 0.f, 0.f}};
#pragma unroll
            for (int ks = 0; ks < 12; ++ks) { bf16x8 a;
                if (ks < 8) a = *(const LAS bf16x8*)(UL + (16 * m + fr) * 264 + ks * 32 + fq * 8); else a = *(const LAS bf16x8*)(HB + (16 * m + fr) * 136 + (ks - 8) * 32 + fq * 8);
                acc[0] = __builtin_amdgcn_mfma_f32_16x16x32_bf16(bY[0][ks], a, acc[0], 0, 0, 0);
                acc[1] = __builtin_amdgcn_mfma_f32_16x16x32_bf16(bY[1][ks], a, acc[1], 0, 0, 0); }
            const int rl = 16 * m + fr;
            if (rl < 129 && (rl > 0 || b == 0)) {
#pragma unroll
                for (int nt = 0; nt < 2; ++nt) { const int t = 2 * w + nt;
                    const v2u xw = *(const LAS v2u*)(UL + rl * 264 + t * 16 + 4 * fq);
                    const float z0 = gelu_tanh_f(acc[nt][0] + dsk.x * bflo(xw.x)), z1 = gelu_tanh_f(acc[nt][1] + dsk.y * bfhi(xw.x));
                    const float z2 = gelu_tanh_f(acc[nt][2] + dsk.z * bflo(xw.y)), z3 = gelu_tanh_f(acc[nt][3] + dsk.w * bfhi(xw.y));
                    const size_t row = (rl == 0) ? (size_t)(R_META + t) : (size_t)b * SEQ + 16 * (rl - 1) + t;
                    v2u o; o.x = pk2(z0, z1); o.y = pk2(z2, z3);
                    *(GAS v2u*)(Z + row * D + 16 * g + 4 * fq) = o; } }
        }
    } else {
        bf16x8 bY0[12];
#pragma unroll
        for (int ks = 0; ks < 12; ++ks) bY0[ks] = *(const GAS bf16x8*)(WY + (size_t)fr * 384 + ks * 32 + fq * 8);
        f32x4 acc = {0.f, 0.f, 0.f, 0.f};
#pragma unroll
        for (int ks = 0; ks < 12; ++ks) { bf16x8 a;
            if (ks < 8) a = *(const LAS bf16x8*)(UL + (16 * w + fr) * 264 + ks * 32 + fq * 8); else a = *(const LAS bf16x8*)(HB + (16 * w + fr) * 136 + (ks - 8) * 32 + fq * 8);
            acc = __builtin_amdgcn_mfma_f32_16x16x32_bf16(bY0[ks], a, acc, 0, 0, 0); }
        const int i = 16 * w + fr;
        const v2u xw = *(const LAS v2u*)(UL + i * 264 + 4 * fq);
        const float z0 = gelu_tanh_f(acc[0] + dsk.x * bflo(xw.x)), z1 = gelu_tanh_f(acc[1] + dsk.y * bfhi(xw.x));
        const float z2 = gelu_tanh_f(acc[2] + dsk.z * bflo(xw.y)), z3 = gelu_tanh_f(acc[3] + dsk.w * bfhi(xw.y));
        v2u o; o.x = pk2(z0, z1); o.y = pk2(z2, z3);
        *(GAS v2u*)(Z + (size_t)(R_SMP + i) * D + 16 * g + 4 * fq) = o;
    }
}

constexpr int N_PHASES = 14;
#ifndef DUP_MASK
#define DUP_MASK 0
#endif
#define NREP(k) (((DUP_MASK >> (k)) & 1) ? 2 : 1)
__global__ void __launch_bounds__(NWAVES * 64, 2) hybrid_fwd(Args args) {
    extern __shared__ __attribute__((aligned(16))) unsigned char lds_raw[];
    Ctx C;
    C.lds = (LAS unsigned char*)lds_raw;
    C.tid = threadIdx.x; C.lane = C.tid & 63; C.wave = __builtin_amdgcn_readfirstlane(C.tid >> 6);
    C.G = gridDim.x; { const int bx = blockIdx.x; C.vcu = (C.G % 8 == 0) ? (bx % 8) * (C.G / 8) + bx / 8 : bx; }
    C.in = args.in; C.out = args.out; C.ws = args.ws;
    volatile LAS unsigned* MISC = (volatile LAS unsigned*)(C.lds + MISC_OFF);
    for (int u = C.tid; u < (LDS_BYTES - LDSCTL_OFF) / 4; u += NWAVES * 64) ((LAS unsigned*)(C.lds + LDSCTL_OFF))[u] = 0u;
    __syncthreads();
    const int lo = args.ph_lo, hi = args.ph_hi;
    XcdBarrier bar; bar.bar = (unsigned*)(C.ws + WS_CTL) + CW_BAR; bar.x = 0; bar.st = nullptr;
    if (hi - lo > 1) bar = xcd_barrier_post((unsigned*)(C.ws + WS_CTL) + CW_BAR, MISC + 8);
#define IN(k) (lo <= (k) && (k) < hi)
#define SEAM(k) do { if (IN(k) && IN((k) + 1)) xcd_barrier(bar); } while (0)
    const float* gain = args.in[I_GAIN];
    bf16* XN = (bf16*)(C.ws + WS_XN); bf16* R1 = (bf16*)(C.ws + WS_R1); bf16* R2 = (bf16*)(C.ws + WS_R2);

    if (IN(0)) { p0_prologue(C); } SEAM(0);
    if (IN(1)) {
        pg8::Gemm g{XN, (const bf16*)(C.ws + WS_W1T), MROWS, 2816, 1024, 1024}; pg8::StaticOrder S; S.init(MROWS, 2816, C.G, (int)blockIdx.x);
        pg8::EpiXG E{R1, (const float*)(C.ws + WS_XEX)};
        pg8::gemm_phase<pg8::EpiXG, pg8::StaticOrder, PG8_ALIGN, PG8_SP2>(C.lds + RING_OFF, g, S, E);
    } SEAM(1);
    if (IN(2)) {
        lru2_block(C);
    } SEAM(2);
    if (IN(3)) {
        pg8::Gemm g{R2, (const bf16*)(C.ws + WS_W2T), 16384, 1024, 1408, 1408}; pg8::StaticOrder S; S.init(16384, 1024, C.G, (int)blockIdx.x);
        pg8::EpiPlain E{R1, 1024};
        pg8::gemm_phase<pg8::EpiPlain, pg8::StaticOrder, PG8_ALIGN, PG8_SP2>(C.lds + RING_OFF, g, S, E);
        pg8::Gemm g2{R2, (const bf16*)(C.ws + WS_W2T), MROWS, 1024, 128, 1408}; pg8::SplitOrder S2{4, 11, 128, C.G, (int)blockIdx.x, 64};
        pg8::EpiSlab E2{(float*)(C.ws + WS_SLAB), 1024};
        pg8::gemm_phase<pg8::EpiSlab, pg8::SplitOrder, PG8_ALIGN, PG8_SP2>(C.lds + RING_OFF, g2, S2, E2);
    } SEAM(3);
    if (IN(4)) { nr_phase<0>(C, R1, gain + 1 * D, gain + 2 * D, 11, 1024, false, 0); } SEAM(4);
    if (IN(5)) {
        pg8::Gemm g{XN, (const bf16*)(C.ws + WS_W3T), MROWS, 5632, 1024, 1024}; pg8::StaticOrder S; S.init(MROWS, 5632, C.G, (int)blockIdx.x);
        pg8::EpiGated<0> E{R1, 2816, (const float*)(C.ws + WS_XEX)};
        pg8::gemm_phase<pg8::EpiGated<0>, pg8::StaticOrder, PG8_ALIGN, PG8_SP2>(C.lds + RING_OFF, g, S, E);
    } SEAM(5);
    if (IN(6)) {
        pg8::Gemm g{R1, (const bf16*)(C.ws + WS_W4T), 16384, 1024, 2816, 2816}; pg8::StaticOrder S; S.init(16384, 1024, C.G, (int)blockIdx.x);
        pg8::EpiPlain E{R2, 1024};
        pg8::gemm_phase<pg8::EpiPlain, pg8::StaticOrder, PG8_ALIGN, PG8_SP2>(C.lds + RING_OFF, g, S, E);
        pg8::Gemm g2{R1, (const bf16*)(C.ws + WS_W4T), MROWS, 1024, 256, 2816}; pg8::SplitOrder S2{4, 11, 256, C.G, (int)blockIdx.x, 64};
        pg8::EpiSlab E2{(float*)(C.ws + WS_SLAB), 1024};
        pg8::gemm_phase<pg8::EpiSlab, pg8::SplitOrder, PG8_ALIGN, PG8_SP2>(C.lds + RING_OFF, g2, S2, E2);
    } SEAM(6);
    if (IN(7)) { nr_phase<1>(C, R2, gain + 3 * D, gain + 4 * D, 11, 1024, false, 0); } SEAM(7);
    if (IN(8)) {
        for (int it = C.vcu; it < 576; it += C.G) s5_item(C, it);
    } SEAM(8);
    if (IN(9)) {
        pg8::Gemm g{R2, (const bf16*)(C.ws + WS_W5T), 16384, 2048, 1024, 1024}; pg8::StaticOrder S; S.init(16384, 2048, C.G, (int)blockIdx.x);
        pg8::EpiGated<1> E{R1, 1024, nullptr};
        pg8::gemm_phase<pg8::EpiGated<1>, pg8::StaticOrder, PG8_ALIGN, PG8_SP2>(C.lds + RING_OFF, g, S, E);
        pg8::Gemm g2{R2, (const bf16*)(C.ws + WS_W5T), MROWS, 2048, 256, 1024}; pg8::SplitOrder S2{8, 4, 256, C.G, (int)blockIdx.x, 64};
        pg8::EpiSlab E2{(float*)(C.ws + WS_SLAB), 2048};
        pg8::gemm_phase<pg8::EpiSlab, pg8::SplitOrder, PG8_ALIGN, PG8_SP2>(C.lds + RING_OFF, g2, S2, E2);
    } SEAM(9);
    if (IN(10)) { nr_phase<2>(C, R1, gain + 5 * D, gain + 6 * D, 4, 2048, true, 0); } SEAM(10);
    if (IN(11)) {
        pg8::Gemm g{XN, (const bf16*)(C.ws + WS_W3T) + (size_t)5632 * 1024, MROWS, 5632, 1024, 1024}; pg8::StaticOrder S; S.init(MROWS, 5632, C.G, (int)blockIdx.x);
        pg8::EpiGated<0> E{R1, 2816, (const float*)(C.ws + WS_XEX)};
        pg8::gemm_phase<pg8::EpiGated<0>, pg8::StaticOrder, PG8_ALIGN, PG8_SP2>(C.lds + RING_OFF, g, S, E);
    } SEAM(11);
    if (IN(12)) {
        pg8::Gemm g{R1, (const bf16*)(C.ws + WS_W4T) + (size_t)1024 * 2816, 16384, 1024, 2816, 2816}; pg8::StaticOrder S; S.init(16384, 1024, C.G, (int)blockIdx.x);
        pg8::EpiPlain E{R2, 1024};
        pg8::gemm_phase<pg8::EpiPlain, pg8::StaticOrder, PG8_ALIGN, PG8_SP2>(C.lds + RING_OFF, g, S, E);
        pg8::Gemm g2{R1, (const bf16*)(C.ws + WS_W4T) + (size_t)1024 * 2816, MROWS, 1024, 256, 2816}; pg8::SplitOrder S2{4, 11, 256, C.G, (int)blockIdx.x, 64};
        pg8::EpiSlab E2{(float*)(C.ws + WS_SLAB), 1024};
        pg8::gemm_phase<pg8::EpiSlab, pg8::SplitOrder, PG8_ALIGN, PG8_SP2>(C.lds + RING_OFF, g2, S2, E2);
    } SEAM(12);
    if (IN(13)) { nr_phase<3>(C, R2, gain + 7 * D, gain, 11, 1024, false, 0); }
#undef IN
#undef SEAM
}

#ifndef MK_ONE_LAUNCH
#define MK_ONE_LAUNCH 1
#endif
extern "C" void kernel_launch(void* const* d_in, const int* in_sizes, int n_in, void* d_out, int out_size, void* d_ws, size_t ws_size, hipStream_t stream) {
    static int grid = 0;
    if (grid == 0) {
        if (n_in != 28 || out_size != (int)O_END || ws_size < WS_END) { fprintf(stderr, "kernel_launch: unexpected shapes: n_in %d out %d ws %zu (need %zu)\n", n_in, out_size, ws_size, (size_t)WS_END); grid = -1; return; }
        int dev = 0, cus = 0, per_cu = 0;
        if (hipGetDevice(&dev) != hipSuccess || hipDeviceGetAttribute(&cus, hipDeviceAttributeMultiprocessorCount, dev) != hipSuccess) { grid = -1; return; }
        if (hipFuncSetAttribute((const void*)hybrid_fwd, hipFuncAttributeMaxDynamicSharedMemorySize, LDS_BYTES) != hipSuccess) { fprintf(stderr, "kernel_launch: hipFuncSetAttribute failed\n"); grid = -1; return; }
        if (hipOccupancyMaxActiveBlocksPerMultiprocessor(&per_cu, (const void*)hybrid_fwd, NWAVES * 64, LDS_BYTES) != hipSuccess || per_cu < 1) { fprintf(stderr, "kernel_launch: occupancy query says %d\n", per_cu); }
        (void)hipGetLastError();
        grid = cus;
        if (grid != 256) fprintf(stderr, "kernel_launch: %d CUs (built for 256)\n", grid);
    }
    if (grid < 0) return;
    (void)in_sizes;
    if (hipMemsetAsync((char*)d_ws + WS_CTL, 0, CTL_ZERO_BYTES, stream) != hipSuccess) return;
    Args a{};
    for (int i = 0; i < 28; ++i) a.in[i] = (const float*)d_in[i];
    a.out = (float*)d_out; a.ws = (unsigned char*)d_ws;
#if MK_ONE_LAUNCH
    a.ph_lo = 0; a.ph_hi = N_PHASES;
    hipLaunchKernelGGL(hybrid_fwd, dim3(grid), dim3(NWAVES * 64), LDS_BYTES, stream, a);
#else
    for (int p = 0; p < N_PHASES; ++p) for (int rep = 0; rep < NREP(p); ++rep) { a.ph_lo = p; a.ph_hi = p + 1;
        hipLaunchKernelGGL(hybrid_fwd, dim3(grid), dim3(NWAVES * 64), LDS_BYTES, stream, a); }
#endif
}
```
